# Optimizing an MI355X kernel written in HIP

```python
import math
import jax, jax.numpy as jnp
from jax import lax
import numpy as np

D_MODEL = 1024
BATCH = 4
SEQ = 4096
DEPTH = 2

HEAD_DIM = 64
HEADS_A = 8
HEADS_B = 8
HEADS_C = 8
WIDTH = HEADS_A * HEAD_DIM
N_BRANCH = 3
ROPE_DIM = HEAD_DIM // 4
ROPE_THETA = 500000.0
MOBA_BLOCK = 256
MOBA_TOPK = 3
MOBA_Q_CHUNK = 32
IDX_HEADS = 8
IDX_DIM = 64
DSA_TOPK_MAX = 256
Q_BLOCK = 128
RMS_EPS = 1e-6

SECTION_SIZES = (
    WIDTH, WIDTH, WIDTH, WIDTH,
    WIDTH, WIDTH, WIDTH, WIDTH,
    WIDTH, WIDTH, WIDTH, WIDTH,
    IDX_HEADS * IDX_DIM, IDX_DIM, IDX_HEADS,
    HEADS_C,
    N_BRANCH * D_MODEL,
)
D_IN = sum(SECTION_SIZES)
SPLIT_POINTS = tuple(int(v) for v in np.cumsum(SECTION_SIZES)[:-1])

kernel_name = "hybrid_moba_dsa_fox_gated_trunk"


def rms_norm(x, gain):
    xf = x.astype(jnp.float32)
    y = xf * lax.rsqrt(jnp.mean(xf * xf, axis=-1, keepdims=True) + RMS_EPS)
    return (y * gain.astype(jnp.float32)).astype(x.dtype)


def rope_partial(t, pos):
    half = ROPE_DIM // 2
    inv_freq = jnp.power(jnp.float32(ROPE_THETA), -jnp.arange(0, ROPE_DIM, 2, dtype=jnp.float32) / ROPE_DIM)
    ang = pos.astype(jnp.float32)[:, None] * inv_freq[None, :]
    cos = jnp.cos(ang)[None, :, None, :]
    sin = jnp.sin(ang)[None, :, None, :]
    tr = t[..., :ROPE_DIM].astype(jnp.float32)
    t1, t2 = tr[..., :half], tr[..., half:]
    rot = jnp.concatenate([t1 * cos - t2 * sin, t2 * cos + t1 * sin], axis=-1).astype(t.dtype)
    return jnp.concatenate([rot, t[..., ROPE_DIM:]], axis=-1)


def moba_attention(q, k, v):
    B, S, H, d = q.shape
    n_blk = -(-S // MOBA_BLOCK)
    pad = n_blk * MOBA_BLOCK - S
    kp = jnp.pad(k, ((0, 0), (0, pad), (0, 0), (0, 0)))
    vp = jnp.pad(v, ((0, 0), (0, pad), (0, 0), (0, 0)))
    kb = kp.reshape(B, n_blk, MOBA_BLOCK, H, d).transpose(0, 3, 1, 2, 4)
    vb = vp.reshape(B, n_blk, MOBA_BLOCK, H, d).transpose(0, 3, 1, 2, 4)
    k_mean = jnp.mean(kb, axis=3)
    qh = q.transpose(0, 2, 1, 3)
    k_sel = min(MOBA_TOPK, n_blk - 1)
    scale = d ** -0.5
    bi = jnp.arange(B)[:, None, None, None]
    hi = jnp.arange(H)[None, :, None, None]

    def chunk(ci):
        start = ci * MOBA_Q_CHUNK
        qc = lax.dynamic_slice_in_dim(qh, start, MOBA_Q_CHUNK, axis=2)
        qpos = start + jnp.arange(MOBA_Q_CHUNK)
        own = start // MOBA_BLOCK
        k_own = lax.dynamic_index_in_dim(kb, own, axis=2, keepdims=False)
        v_own = lax.dynamic_index_in_dim(vb, own, axis=2, keepdims=False)
        kpos_own = own * MOBA_BLOCK + jnp.arange(MOBA_BLOCK)
        s_own = jnp.einsum('bhqd,bhkd->bhqk', qc, k_own).astype(jnp.float32) * scale
        s_own = jnp.where(kpos_own[None, :] <= qpos[:, None], s_own, -jnp.inf)
        if k_sel == 0:
            p = jax.nn.softmax(s_own, axis=-1).astype(v.dtype)
            return jnp.einsum('bhqk,bhkd->bhqd', p, v_own)
        gate = jnp.einsum('bhqd,bhnd->bhqn', qc, k_mean).astype(jnp.float32)
        gate = jnp.where((jnp.arange(n_blk) < own)[None, None, None, :], gate, -jnp.inf)
        gval, gidx = lax.top_k(gate, k_sel)
        ok = gval > -jnp.inf
        k_g = kb[bi, hi, gidx]
        v_g = vb[bi, hi, gidx]
        s_past = jnp.einsum('bhqd,bhqnkd->bhqnk', qc, k_g).astype(jnp.float32) * scale
        s_past = jnp.where(ok[..., None], s_past, -jnp.inf)
        s_past = s_past.reshape(B, H, MOBA_Q_CHUNK, k_sel * MOBA_BLOCK)
        p = jax.nn.softmax(jnp.concatenate([s_past, s_own], axis=-1), axis=-1).astype(v.dtype)
        p_past = p[..., :k_sel * MOBA_BLOCK].reshape(B, H, MOBA_Q_CHUNK, k_sel, MOBA_BLOCK)
        p_own = p[..., k_sel * MOBA_BLOCK:]
        return (jnp.einsum('bhqnk,bhqnkd->bhqd', p_past, v_g)
                + jnp.einsum('bhqk,bhkd->bhqd', p_own, v_own))

    out = lax.map(chunk, jnp.arange(S // MOBA_Q_CHUNK))
    return out.transpose(1, 0, 3, 2, 4).reshape(B, S, H, d)


def dsa_attention(q, k, v, q_idx, k_idx, w_idx):
    B, S, H, d = q.shape
    top = min(DSA_TOPK_MAX, S // 4)
    scale = d ** -0.5
    bi = jnp.arange(B)[:, None, None]
    kpos = jnp.arange(S)

    def chunk(ci):
        start = ci * Q_BLOCK
        qpos = start + jnp.arange(Q_BLOCK)
        qi = lax.dynamic_slice_in_dim(q_idx, start, Q_BLOCK, axis=1)
        wi = lax.dynamic_slice_in_dim(w_idx, start, Q_BLOCK, axis=1)
        rel = jax.nn.relu(jnp.einsum('bqhd,bsd->bqhs', qi, k_idx))
        isc = jnp.einsum('bqh,bqhs->bqs', wi, rel).astype(jnp.float32)
        isc = jnp.where(kpos[None, None, :] <= qpos[None, :, None], isc, -jnp.inf)
        ival, idx = lax.top_k(isc, top)
        ok = ival > -jnp.inf
        k_g = k[bi, idx]
        v_g = v[bi, idx]
        qc = lax.dynamic_slice_in_dim(q, start, Q_BLOCK, axis=1)
        s = jnp.einsum('bqhd,bqkhd->bhqk', qc, k_g).astype(jnp.float32) * scale
        s = jnp.where(ok[:, None], s, -jnp.inf)
        p = jax.nn.softmax(s, axis=-1).astype(v.dtype)
        return jnp.einsum('bhqk,bqkhd->bqhd', p, v_g)

    out = lax.map(chunk, jnp.arange(S // Q_BLOCK))
    return out.transpose(1, 0, 2, 3, 4).reshape(B, S, H, d)


def forgetting_attention(q, k, v, log_f):
    B, S, H, d = q.shape
    scale = d ** -0.5
    csum = jnp.cumsum(log_f, axis=1).transpose(0, 2, 1)
    qh = q.transpose(0, 2, 1, 3)
    kh = k.transpose(0, 2, 1, 3)
    vh = v.transpose(0, 2, 1, 3)
    kpos = jnp.arange(S)

    def chunk(ci):
        start = ci * Q_BLOCK
        qpos = start + jnp.arange(Q_BLOCK)
        qc = lax.dynamic_slice_in_dim(qh, start, Q_BLOCK, axis=2)
        cq = lax.dynamic_slice_in_dim(csum, start, Q_BLOCK, axis=2)
        s = jnp.einsum('bhqd,bhkd->bhqk', qc, kh).astype(jnp.float32) * scale
        s = s + (cq[..., :, None] - csum[:, :, None, :])
        s = jnp.where(kpos[None, :] <= qpos[:, None], s, -jnp.inf)
        p = jax.nn.softmax(s, axis=-1).astype(v.dtype)
        return jnp.einsum('bhqk,bhkd->bhqd', p, vh)

    out = lax.map(chunk, jnp.arange(S // Q_BLOCK))
    return out.transpose(1, 0, 3, 2, 4).reshape(B, S, H, d)


def hybrid_layer(x, gain, w_in, f_bias, w_branch, w_out):
    B, S, _ = x.shape
    pos = jnp.arange(S)
    h = rms_norm(x, gain)
    proj = jnp.einsum('bsd,de->bse', h, w_in)
    (qa, ka, va, ga, qb, kb_, vb_, gb, qc, kc, vc, gc,
     q_idx, k_idx, w_idx, f_logit, merge_logit) = jnp.split(proj, SPLIT_POINTS, axis=-1)

    def heads(t, n):
        return t.reshape(B, S, n, HEAD_DIM)

    oa = moba_attention(rope_partial(heads(qa, HEADS_A), pos), rope_partial(heads(ka, HEADS_A), pos),
                        heads(va, HEADS_A)).reshape(B, S, WIDTH) * jax.nn.silu(ga)
    qi = rope_partial(q_idx.reshape(B, S, IDX_HEADS, IDX_DIM), pos)
    ki = rope_partial(k_idx[:, :, None, :], pos)[:, :, 0, :]
    wi = w_idx * (IDX_HEADS ** -0.5 * IDX_DIM ** -0.5)
    ob = dsa_attention(rope_partial(heads(qb, HEADS_B), pos), rope_partial(heads(kb_, HEADS_B), pos),
                       heads(vb_, HEADS_B), qi, ki, wi).reshape(B, S, WIDTH) * jax.nn.silu(gb)
    log_f = jax.nn.log_sigmoid((f_logit + f_bias).astype(jnp.float32))
    oc = forgetting_attention(heads(qc, HEADS_C), heads(kc, HEADS_C), heads(vc, HEADS_C),
                              log_f).reshape(B, S, WIDTH) * jax.nn.silu(gc)

    y = jnp.einsum('nbsw,nwd->bsnd', jnp.stack([oa, ob, oc], axis=0), w_branch)
    gates = jax.nn.sigmoid(merge_logit).reshape(B, S, N_BRANCH, D_MODEL)
    merged = jnp.sum(gates * y, axis=2)
    return x + jnp.einsum('bsd,de->bse', merged, w_out)


def setup_inputs(seed: int = 0) -> dict:
    key = jax.random.key(seed)
    ks = jax.random.split(key, 8)
    x = jax.random.normal(ks[0], (BATCH, SEQ, D_MODEL), jnp.float32)
    norm_gain = 1.0 + 0.05 * jax.random.normal(ks[1], (DEPTH, D_MODEL), jnp.float32)
    w_in = jax.random.normal(ks[2], (DEPTH, D_MODEL, D_IN), jnp.float32) * D_MODEL ** -0.5
    forget_bias = 3.0 + 0.5 * jax.random.normal(ks[3], (DEPTH, HEADS_C), jnp.float32)
    w_branch = jax.random.normal(ks[4], (DEPTH, N_BRANCH, WIDTH, D_MODEL), jnp.float32) * WIDTH ** -0.5
    w_out = jax.random.normal(ks[5], (DEPTH, D_MODEL, D_MODEL), jnp.float32) * (0.5 * D_MODEL ** -0.5)
    final_gain = 1.0 + 0.05 * jax.random.normal(ks[6], (D_MODEL,), jnp.float32)
    return {"x": x, "norm_gain": norm_gain, "w_in": w_in, "forget_bias": forget_bias,
            "w_branch": w_branch, "w_out": w_out, "final_gain": final_gain}


def reference(x, norm_gain, w_in, forget_bias, w_branch, w_out, final_gain):
    h = x
    for layer in range(DEPTH):
        h = hybrid_layer(h, norm_gain[layer], w_in[layer], forget_bias[layer],
                         w_branch[layer], w_out[layer])
    return rms_norm(h, final_gain)
```

```cpp
#include <hip/hip_runtime.h>
#include <hip/hip_bf16.h>
#include <hip/hip_cooperative_groups.h>
#include <cstdio>
#include <cstdint>
namespace cg = cooperative_groups;

typedef unsigned short u16;
using bf16x8 = __attribute__((ext_vector_type(8))) short;
using f32x4  = __attribute__((ext_vector_type(4))) float;
using f32x16 = __attribute__((ext_vector_type(16))) float;
using u32x2  = __attribute__((ext_vector_type(2))) unsigned;
using u32x4  = __attribute__((ext_vector_type(4))) unsigned;
#define DI __device__ __forceinline__

constexpr int T_TOK = 16384, SEQ = 4096, NBATCH = 4, DM = 1024, NH = 8, HD = 64, WID = 512;
constexpr int D_IN = 9808;
constexpr int N1 = 6912;
constexpr int N1_VALID = 6736;
constexpr int NMERGE = 3072;
constexpr int NWROWS = N1 + NMERGE;
constexpr float QSCALE = 0.125f * 1.4426950408889634f;
constexpr float LOG2E = 1.4426950408889634f;
constexpr int NTHR = 512;
constexpr int SMEM_BYTES = 8 * 4128 * 4;

constexpr size_t MiB = 1024 * 1024;
constexpr size_t OFF_BAR = 0;
constexpr size_t OFF_ROPE = 16384;
constexpr size_t OFF_RSTD = OFF_ROPE + 262144;
constexpr size_t OFF_WI = OFF_RSTD + 65536;
constexpr size_t OFF_LF = OFF_WI + 524288;
constexpr size_t OFF_CS = OFF_LF + 524288;
constexpr size_t OFF_KMEAN = OFF_CS + 524288;
constexpr size_t OFF_XB = 2 * MiB;
constexpr size_t OFF_WIN = 34 * MiB;
constexpr size_t OFF_WBR = 54 * MiB;
constexpr size_t OFF_WOUT = 57 * MiB;
constexpr size_t OFF_MASK = 59 * MiB;
constexpr size_t OFF_KI = 67 * MiB;
constexpr size_t OFF_QI = 69 * MiB;
constexpr size_t OFF_Q0 = 85 * MiB;
constexpr size_t OFF_VT0 = 181 * MiB;
constexpr size_t OFF_G0 = 229 * MiB;
constexpr size_t WS_NEED = 277 * MiB;
constexpr size_t OFF_MERGED = OFF_Q0;
constexpr size_t OFF_SCR = 117 * MiB;

struct Params {
  const float* x; const float* norm_gain; const float* w_in; const float* fbias;
  const float* w_branch; const float* w_out; const float* final_gain;
  float* out; char* ws;
};

DI unsigned pk2(float a, float b) {
  typedef __bf16 bf2 __attribute__((ext_vector_type(2)));
  typedef float f2 __attribute__((ext_vector_type(2)));
  f2 v = {a, b};
  bf2 r = __builtin_convertvector(v, bf2);
  return __builtin_bit_cast(unsigned, r);
}
DI u16 f2bf(float a) { return (u16)(pk2(a, 0.f) & 0xffffu); }
DI float bf2f(unsigned v) { return __uint_as_float(v << 16); }
DI float wave_sum(float v) {
#pragma unroll
  for (int o = 32; o > 0; o >>= 1) v += __shfl_xor(v, o);
  return v;
}
DI int wave_sum_i(int v) {
#pragma unroll
  for (int o = 32; o > 0; o >>= 1) v += __shfl_xor(v, o);
  return v;
}
DI int ltid() { int t = threadIdx.x; asm volatile("" : "+v"(t)); return t; }
DI float fast_exp2(float x) { return __builtin_amdgcn_exp2f(x); }

DI void tr_tile(const float* __restrict__ src, int src_ld, int k0, int n0, int mode, u16* __restrict__ dst, int dst_ld,
                const float* __restrict__ gain, float* lds) {
  const int tid = ltid();
  {
    const int tx = tid & 63, ty = tid >> 6;
    const int n = n0 + tx;
    int c = n;
    if (mode == 1) c = (n < N1_VALID) ? n : (n >= N1 ? n - (N1 - N1_VALID) : -1);
#pragma unroll
    for (int i = 0; i < 8; ++i) {
      const int kk = ty + 8 * i;
      const int k = k0 + kk;
      float v = 0.f;
      if (c >= 0) v = src[(size_t)k * src_ld + c];
      if (gain) v *= gain[k];
      lds[kk * 65 + tx] = v;
    }
  }
  __syncthreads();
  {
    const int kx = (tid & 31) * 2, ny = tid >> 5;
#pragma unroll
    for (int i = 0; i < 4; ++i) {
      const int nn = ny + 16 * i;
      const unsigned pv = pk2(lds[kx * 65 + nn], lds[(kx + 1) * 65 + nn]);
      *(unsigned*)(dst + (size_t)(n0 + nn) * dst_ld + k0 + kx) = pv;
    }
  }
  __syncthreads();
}

DI void phase_prep(const Params& p, int layer) {
  extern __shared__ __attribute__((aligned(16))) char smem[];
  float* lds = (float*)smem;
  const int tid = ltid(), wave = tid >> 6, lane = tid & 63;
  const int G = gridDim.x, g = blockIdx.x;
  if (layer == 0) {
    float2* rope = (float2*)(p.ws + OFF_ROPE);
    for (int e = g * NTHR + tid; e < SEQ * 8; e += G * NTHR) {
      const int pos = e >> 3, i = e & 7;
      const float invf = i == 0 ? 1.0f : i == 1 ? 0.1939227432012558f : i == 2 ? 0.03760603070259094f : i == 3 ? 0.007292664609849453f
                       : i == 4 ? 0.0014142135623842478f : i == 5 ? 0.00027424818836152554f : i == 6 ? 5.3182957344688475e-05f : 1.0313385246263351e-05f;
      const float ang = (float)pos * invf;
      const float kf = rintf(ang * 0.6366197723675814f);
      const int kq = (int)kf;
      float rr = fmaf(kf, -1.5703125f, ang);
      rr = fmaf(kf, -4.837512969970703125e-4f, rr);
      rr = fmaf(kf, -7.54978995489188216e-8f, rr);
      const float r2 = rr * rr;
      float ks3 = -1.9515295891e-4f, kc3 = 2.443315711809948e-5f;
      asm volatile("" : "+v"(ks3), "+v"(kc3));
      const float sp = fmaf(rr * r2, fmaf(r2, fmaf(r2, ks3, 8.3321608736e-3f), -1.6666654611e-1f), rr);
      const float cp = fmaf(r2 * r2, fmaf(r2, fmaf(r2, kc3, -1.388731625493765e-3f), 4.166664568298827e-2f), fmaf(r2, -0.5f, 1.0f));
      float sn, cs;
      if ((kq & 3) == 0) { sn = sp; cs = cp; } else if ((kq & 3) == 1) { sn = cp; cs = -sp; } else if ((kq & 3) == 2) { sn = -sp; cs = -cp; } else { sn = -cp; cs = sp; }
      rope[e] = make_float2(cs, sn);
    }
  }
  {
    const float* src = layer == 0 ? p.x : p.out;
    u16* xb = (u16*)(p.ws + OFF_XB);
    float* rstd = (float*)(p.ws + OFF_RSTD);
    for (int row = g * 8 + wave; row < T_TOK; row += G * 8) {
      const float4* s4 = (const float4*)(src + (size_t)row * DM);
      float ss = 0.f;
      float4 v[4];
#pragma unroll
      for (int i = 0; i < 4; ++i) { v[i] = s4[lane + 64 * i]; ss += v[i].x * v[i].x + v[i].y * v[i].y + v[i].z * v[i].z + v[i].w * v[i].w; }
      ss = wave_sum(ss);
#pragma unroll
      for (int i = 0; i < 4; ++i) {
        u32x2 o; o[0] = pk2(v[i].x, v[i].y); o[1] = pk2(v[i].z, v[i].w);
        *(u32x2*)(xb + (size_t)row * DM + (lane + 64 * i) * 4) = o;
      }
      if (lane == 0) rstd[row] = rsqrtf(ss * (1.0f / DM) + 1e-6f);
    }
  }
  {
    const float* w_in = p.w_in + (size_t)layer * DM * D_IN;
    const float* gain = p.norm_gain + (size_t)layer * DM;
    const float* w_br = p.w_branch + (size_t)layer * 3 * WID * DM;
    const float* w_out = p.w_out + (size_t)layer * DM * DM;
    u16* win_t = (u16*)(p.ws + OFF_WIN);
    u16* wbr_t = (u16*)(p.ws + OFF_WBR);
    u16* wout_t = (u16*)(p.ws + OFF_WOUT);
    constexpr int NT_IN = 16 * (NWROWS / 64);
    constexpr int NT_BR = 3 * 8 * 16;
    constexpr int NT_OUT = 16 * 16;
    for (int t = g; t < NT_IN + NT_BR + NT_OUT; t += G) {
      if (t < NT_IN) {
        const int kt = t & 15, nt = t >> 4;
        tr_tile(w_in, D_IN, kt * 64, nt * 64, 1, win_t, DM, gain, lds);
      } else if (t < NT_IN + NT_BR) {
        const int u = t - NT_IN; const int nb = u / 128, r = u % 128; const int kt = r & 7, nt = r >> 3;
        tr_tile(w_br + (size_t)nb * WID * DM, DM, kt * 64, nt * 64, 0, wbr_t + (size_t)nb * DM * WID, WID, nullptr, lds);
      } else {
        const int u = t - NT_IN - NT_BR; const int kt = u & 15, nt = u >> 4;
        tr_tile(w_out, DM, kt * 64, nt * 64, 0, wout_t, DM, nullptr, lds);
      }
    }
  }
}

constexpr int G_BK = 64, G_HALF = 128, G_HT = G_HALF * G_BK;
DI int lds_byte(int r, int c) {
  int st = (r >> 4) * 2 + (c >> 5), rr = r & 15, cc = c & 31, ob = rr * 64 + cc * 2;
  return st * 1024 + (ob ^ (((ob >> 9) & 1) << 5));
}
DI void stage_rc(int b, int& R, int& C) {
  int st = b / 1024, sb = b % 1024, swz = sb ^ (((sb >> 9) & 1) << 5);
  R = (st >> 1) * 16 + swz / 64; C = (st & 1) * 32 + (swz % 64) / 2;
}

template <class Epi>
DI void gemm_unit(const u16* __restrict__ A, int lda, const u16* __restrict__ Bt, int ldb, int K, int brow, int bcol, Epi&& epi) {
  extern __shared__ __attribute__((aligned(16))) char smem[];
  u16* shm = (u16*)smem;
#define SA(b, h) (shm + ((b) * 2 + (h)) * G_HT)
#define SB(b, h) (shm + (4 + (b) * 2 + (h)) * G_HT)
#define STAGE_(P, BASE, LD, br, kt, _o0, _o1) do { const char* _gp = (const char*)((BASE) + ((size_t)(br) * (LD) + (size_t)(kt) * G_BK)); \
    __builtin_amdgcn_global_load_lds((const unsigned*)(_gp + (size_t)(_o0)), \
        (__attribute__((address_space(3))) unsigned*)((char*)(P) + tidl * 16), 16, 0, 0); \
    __builtin_amdgcn_global_load_lds((const unsigned*)(_gp + (size_t)(_o1)), \
        (__attribute__((address_space(3))) unsigned*)((char*)(P) + tidl * 16 + 8192), 16, 0, 0); } while (0)
#define STAGE(P, BASE, LD, br, kt) STAGE_SEL_##BASE(P, LD, br, kt)
#define STAGE_SEL_A(P, LD, br, kt) STAGE_(P, A, LD, br, kt, offA0, offA1)
#define STAGE_SEL_Bt(P, LD, br, kt) STAGE_(P, Bt, LD, br, kt, offB0, offB1)
#define LDA(dst, b, h) for (int m = 0; m < 4; ++m) for (int k = 0; k < 2; ++k) \
    dst[m][k] = *reinterpret_cast<const bf16x8*>((char*)SA(b, h) + lds_byte(wr * 64 + m * 16 + fr, k * 32 + fq * 8))
#define LDB(dst, b, h) for (int n = 0; n < 2; ++n) for (int k = 0; k < 2; ++k) \
    dst[n][k] = *reinterpret_cast<const bf16x8*>((char*)SB(b, h) + lds_byte(wc * 32 + n * 16 + fr, k * 32 + fq * 8))
#define MMA(ai, bj, At, Bt_) do { __builtin_amdgcn_s_setprio(1); \
    for (int m = 0; m < 4; ++m) for (int n = 0; n < 2; ++n) for (int k = 0; k < 2; ++k) \
      acc[ai][bj][m][n] = __builtin_amdgcn_mfma_f32_16x16x32_bf16(At[m][k], Bt_[n][k], acc[ai][bj][m][n], 0, 0, 0); \
    __builtin_amdgcn_s_setprio(0); } while (0)
#define WAIT_V(n) asm volatile("s_waitcnt vmcnt(" #n ")" ::: "memory")
#define WAIT_L(n) asm volatile("s_waitcnt lgkmcnt(" #n ")" ::: "memory")
#define BAR __builtin_amdgcn_s_barrier()
#define SCHED __builtin_amdgcn_sched_barrier(0)
  int tidl = threadIdx.x; asm volatile("" : "+v"(tidl));
  const int wid = __builtin_amdgcn_readfirstlane(tidl >> 6), lane = tidl & 63, wr = wid >> 2, wc = wid & 3, fr = lane & 15, fq = lane >> 4;
  f32x4 acc[2][2][4][2] = {};
  bf16x8 At[4][2], B0[2][2], B1[2][2];
  const int nt = K / G_BK;
  unsigned offA0, offA1, offB0, offB1;
  { int _r, _c; stage_rc(tidl * 16, _r, _c); offA0 = (unsigned)(_r * lda + _c) * 2u; offB0 = (unsigned)(_r * ldb + _c) * 2u;
    stage_rc(tidl * 16 + 8192, _r, _c); offA1 = (unsigned)(_r * lda + _c) * 2u; offB1 = (unsigned)(_r * ldb + _c) * 2u; }
  STAGE(SB(0, 0), Bt, ldb, bcol, 0); STAGE(SA(0, 0), A, lda, brow, 0);
  STAGE(SB(0, 1), Bt, ldb, bcol + G_HALF, 0); STAGE(SA(0, 1), A, lda, brow + G_HALF, 0);
  if (wr == 1) BAR;
  WAIT_V(4); BAR;
  STAGE(SB(1, 0), Bt, ldb, bcol, 1); STAGE(SA(1, 0), A, lda, brow, 1); STAGE(SB(1, 1), Bt, ldb, bcol + G_HALF, 1);
  WAIT_V(6); BAR;
  for (int t = 0; t < nt - 2; t += 2) {
    LDB(B0, 0, 0); SCHED; LDA(At, 0, 0); STAGE(SA(1, 1), A, lda, brow + G_HALF, t + 1);
    WAIT_L(8); BAR; WAIT_L(0); MMA(0, 0, At, B0); BAR; SCHED;
    LDB(B1, 0, 1); STAGE(SB(0, 0), Bt, ldb, bcol, t + 2);
    BAR; WAIT_L(0); MMA(0, 1, At, B1); BAR;
    LDA(At, 0, 1); STAGE(SA(0, 0), A, lda, brow, t + 2);
    BAR; WAIT_L(0); MMA(1, 0, At, B0); BAR; SCHED;
    STAGE(SB(0, 1), Bt, ldb, bcol + G_HALF, t + 2);
    WAIT_V(6); BAR; MMA(1, 1, At, B1); BAR;
    LDB(B0, 1, 0); SCHED; LDA(At, 1, 0); STAGE(SA(0, 1), A, lda, brow + G_HALF, t + 2);
    WAIT_L(8); BAR; WAIT_L(0); MMA(0, 0, At, B0); BAR; SCHED;
    LDB(B1, 1, 1); STAGE(SB(1, 0), Bt, ldb, bcol, t + 3);
    BAR; WAIT_L(0); MMA(0, 1, At, B1); BAR;
    LDA(At, 1, 1); STAGE(SA(1, 0), A, lda, brow, t + 3);
    BAR; WAIT_L(0); MMA(1, 0, At, B0); BAR; SCHED;
    STAGE(SB(1, 1), Bt, ldb, bcol + G_HALF, t + 3);
    WAIT_V(6); BAR; MMA(1, 1, At, B1); BAR;
  }
  { LDB(B0, 0, 0); LDA(At, 0, 0); STAGE(SA(1, 1), A, lda, brow + G_HALF, nt - 1);
    BAR; WAIT_L(0); MMA(0, 0, At, B0); BAR;
    LDB(B1, 0, 1); BAR; WAIT_L(0); MMA(0, 1, At, B1); BAR;
    LDA(At, 0, 1); WAIT_V(4); BAR; WAIT_L(0); MMA(1, 0, At, B0); MMA(1, 1, At, B1); BAR; }
  { LDB(B0, 1, 0); LDA(At, 1, 0); WAIT_V(2); BAR; WAIT_L(0); MMA(0, 0, At, B0); BAR;
    LDB(B1, 1, 1); WAIT_V(0); BAR; WAIT_L(0); MMA(0, 1, At, B1); BAR;
    LDA(At, 1, 1); BAR; WAIT_L(0); MMA(1, 0, At, B0); MMA(1, 1, At, B1); BAR; }
  if (wr == 0) BAR;
#define EPI1(ai, bj, m, n) { int _r0 = brow + ai * 128 + wr * 64 + m * 16 + fq * 4, _c0 = bcol + bj * 128 + wc * 32 + n * 16 + fr; asm volatile("" : "+v"(_r0), "+v"(_c0)); epi(ai, bj, m, n, acc[ai][bj][m][n], _r0, _c0); SCHED; }
#define EPI4(ai, bj) EPI1(ai, bj, 0, 0) EPI1(ai, bj, 0, 1) EPI1(ai, bj, 1, 0) EPI1(ai, bj, 1, 1) EPI1(ai, bj, 2, 0) EPI1(ai, bj, 2, 1) EPI1(ai, bj, 3, 0) EPI1(ai, bj, 3, 1)
  EPI4(0, 0) EPI4(0, 1) EPI4(1, 0) EPI4(1, 1)
#undef EPI1
#undef EPI4
#undef SA
#undef SB
#undef STAGE
#undef STAGE_
#undef STAGE_SEL_A
#undef STAGE_SEL_Bt
#undef LDA
#undef LDB
#undef MMA
}

DI void phase_proj(const Params& p, int layer) {
  const u16* xb = (const u16*)(p.ws + OFF_XB);
  const u16* win_t = (const u16*)(p.ws + OFF_WIN);
  const float* rstd = (const float*)(p.ws + OFF_RSTD);
  const float2* rope = (const float2*)(p.ws + OFF_ROPE);
  const float* fb = p.fbias + layer * 8;
  const int tid_ = ltid(), lane = tid_ & 63, wid = tid_ >> 6, wc = wid & 3, fr = lane & 15;
  constexpr int NU = 64 * 27;
  for (int u = blockIdx.x; u < NU; u += gridDim.x) {
    const int pn = u / 64, pm = u % 64;
    const int brow = pm * 256, bcol = pn * 256;
    char* ws = p.ws;
    gemm_unit(xb, DM, win_t, DM, DM, brow, bcol,
      [&](int ai, int bj, int m, int n, f32x4 a, int row0, int col) {
        float v[4];
#pragma unroll
        for (int j = 0; j < 4; ++j) v[j] = a[j] * rstd[row0 + j];
        if (pn < 26) {
          const int sec = pn >> 1;
          const int br = sec >> 2, kind = (pn < 24) ? (sec & 3) : 0;
          const int c = col - sec * 512;
          const bool rope_on = (pn >= 24) || ((kind == 0 || kind == 1) && br < 2);
          if (rope_on && n == 0 && (wc & 1) == 0) {
            const int i = fr & 7; const float sg = (fr < 8) ? -1.f : 1.f;
#pragma unroll
            for (int j = 0; j < 4; ++j) {
              const float pr = __shfl_xor(v[j], 8);
              const float2 cs = rope[((row0 + j) & (SEQ - 1)) * 8 + i];
              v[j] = v[j] * cs.x + sg * pr * cs.y;
            }
          }
          if (pn >= 24) {
            u16* qi = (u16*)(ws + OFF_QI);
#pragma unroll
            for (int j = 0; j < 4; ++j) qi[(size_t)(row0 + j) * 512 + c] = f2bf(v[j]);
          } else if (kind == 0) {
            u16* q = (u16*)(ws + OFF_Q0 + (size_t)br * 32 * MiB);
#pragma unroll
            for (int j = 0; j < 4; ++j) q[(size_t)(row0 + j) * 512 + c] = f2bf(v[j] * QSCALE);
          } else if (kind == 1) {
            u16* k = (u16*)(ws + OFF_Q0 + (size_t)br * 32 * MiB + 16 * MiB);
#pragma unroll
            for (int j = 0; j < 4; ++j) k[(size_t)(row0 + j) * 512 + c] = f2bf(v[j]);
          } else if (kind == 2) {
            u16* vt = (u16*)(ws + OFF_VT0 + (size_t)br * 16 * MiB);
            const int b = row0 >> 12, s = row0 & (SEQ - 1);
            u32x2 o; o[0] = pk2(v[0], v[1]); o[1] = pk2(v[2], v[3]);
            *(u32x2*)(vt + ((size_t)(b * 8 + (c >> 6)) * 64 + (c & 63)) * SEQ + s) = o;
          } else {
            u16* gp = (u16*)(ws + OFF_G0 + (size_t)br * 16 * MiB);
#pragma unroll
            for (int j = 0; j < 4; ++j) { const float x = v[j]; gp[(size_t)(row0 + j) * 512 + c] = f2bf(x / (1.f + __expf(-x))); }
          }
        } else {
          const int c = col - 26 * 256;
          if (c < 64) {
            if (c < 16) {
              const int i = fr & 7; const float sg = (fr < 8) ? -1.f : 1.f;
#pragma unroll
              for (int j = 0; j < 4; ++j) {
                const float pr = __shfl_xor(v[j], 8);
                const float2 cs = rope[((row0 + j) & (SEQ - 1)) * 8 + i];
                v[j] = v[j] * cs.x + sg * pr * cs.y;
              }
            }
            u16* ki = (u16*)(ws + OFF_KI);
#pragma unroll
            for (int j = 0; j < 4; ++j) ki[(size_t)(row0 + j) * 64 + c] = f2bf(v[j]);
          } else if (c < 72) {
            float* wi = (float*)(ws + OFF_WI);
#pragma unroll
            for (int j = 0; j < 4; ++j) wi[(size_t)(row0 + j) * 8 + (c - 64)] = v[j] * 0.04419417382415922f;
          } else if (c < 80) {
            float* lf = (float*)(ws + OFF_LF);
            const float bias = fb[c - 72];
#pragma unroll
            for (int j = 0; j < 4; ++j) { const float z = v[j] + bias; lf[(size_t)(row0 + j) * 8 + (c - 72)] = fminf(z, 0.f) - log1pf(__expf(-fabsf(z))); }
          }
        }
      });
  }
}

DI unsigned umap(float f) { unsigned u = __float_as_uint(f); return (u & 0x80000000u) ? ~u : (u | 0x80000000u); }

DI void select_item(const Params& p, int b, int t0) {
  extern __shared__ __attribute__((aligned(16))) char smem[];
  unsigned* sc = (unsigned*)smem;
  const int tid = ltid(), wave = tid >> 6, lane = tid & 63, r = lane & 31, half = lane >> 5;
  const u16* qi = (const u16*)(p.ws + OFF_QI);
  const u16* ki = (const u16*)(p.ws + OFF_KI);
  const float* wi = (const float*)(p.ws + OFF_WI);
  const int nkt = t0 / 32 + 1;
  {
    bf16x8 aq[2][4];
    const int i_ = (r & 3) | ((r >> 3) << 2), hh = (r >> 2) & 1;
#pragma unroll
    for (int be = 0; be < 2; ++be) {
      const int qloc = 4 * be + 2 * hh + (i_ >> 3), head = i_ & 7;
      const u16* src = qi + (size_t)(b * SEQ + t0 + qloc) * 512 + head * 64 + 8 * half;
#pragma unroll
      for (int ks = 0; ks < 4; ++ks) aq[be][ks] = *(const bf16x8*)(src + 16 * ks);
    }
    float wv[2][16];
#pragma unroll
    for (int be = 0; be < 2; ++be)
#pragma unroll
      for (int e = 0; e < 2; ++e) {
        const float4* w4 = (const float4*)(wi + (size_t)(b * SEQ + t0 + 4 * be + 2 * half + e) * 8);
        const float4 a = w4[0], c = w4[1];
        wv[be][8 * e + 0] = a.x; wv[be][8 * e + 1] = a.y; wv[be][8 * e + 2] = a.z; wv[be][8 * e + 3] = a.w;
        wv[be][8 * e + 4] = c.x; wv[be][8 * e + 5] = c.y; wv[be][8 * e + 6] = c.z; wv[be][8 * e + 7] = c.w;
      }
    for (int kt = wave; kt < nkt; kt += 8) {
      const int key = 32 * kt + r;
      const u16* ksrc = ki + (size_t)(b * SEQ + key) * 64 + 8 * half;
      bf16x8 bk[4];
#pragma unroll
      for (int ks = 0; ks < 4; ++ks) bk[ks] = *(const bf16x8*)(ksrc + 16 * ks);
#pragma unroll
      for (int be = 0; be < 2; ++be) {
        f32x16 c;
#pragma unroll
        for (int i = 0; i < 16; ++i) c[i] = 0.f;
#pragma unroll
        for (int ks = 0; ks < 4; ++ks) c = __builtin_amdgcn_mfma_f32_32x32x16_bf16(aq[be][ks], bk[ks], c, 0, 0, 0);
#pragma unroll
        for (int e = 0; e < 2; ++e) {
          float s = 0.f;
#pragma unroll
          for (int i = 0; i < 8; ++i) s = fmaf(wv[be][8 * e + i], fmaxf(c[8 * e + i], 0.f), s);
          if (s == 0.f) s = 0.f;
          const int q = 4 * be + 2 * half + e;
          sc[q * 4128 + key] = (key <= t0 + q) ? umap(s) : 0u;
        }
      }
    }
  }
  __syncthreads();
  {
    const int t = t0 + wave;
    const int L = t + 1;
    const int nvalid = 32 * nkt;
    const int nreg = (nvalid + 63) >> 6;
    unsigned v[64];
#pragma unroll
    for (int j = 0; j < 64; ++j) {
      v[j] = 0u;
      if (j < nreg) { const int key = 64 * j + lane; if (key < nvalid) v[j] = sc[wave * 4128 + key]; }
    }
    unsigned thr = 1u;
    int need_eq = -1;
    if (L > 256) {
      unsigned P = 0u; bool done = false;
      for (int bit = 31; bit >= 0; --bit) {
        const unsigned cand = P | (1u << bit);
        int c = 0;
#pragma unroll
        for (int j = 0; j < 64; ++j) if (j < nreg) c += __popcll(__ballot(v[j] >= cand));
        if (c >= 256) P = cand;
        if (c == 256) { done = true; break; }
      }
      thr = P;
      if (!done) {
        int cge = 0, cgt = 0;
#pragma unroll
        for (int j = 0; j < 64; ++j) if (j < nreg) { cge += __popcll(__ballot(v[j] >= P)); cgt += __popcll(__ballot(v[j] > P)); }
        if (cge > 256) need_eq = 256 - cgt;
      }
    }
    unsigned long long mine = 0ull;
    int eq_seen = 0;
#pragma unroll
    for (int j = 0; j < 64; ++j) {
      if (j < nreg) {
        bool sel = v[j] >= thr;
        if (need_eq >= 0) {
          const bool eq = v[j] == thr;
          const unsigned long long eb = __ballot(eq);
          const int rank = eq_seen + __popcll(eb & ((1ull << lane) - 1ull));
          sel = (v[j] > thr) || (eq && rank < need_eq);
          eq_seen += __popcll(eb);
        }
        const unsigned long long bm = __ballot(sel);
        if (lane == j) mine = bm;
      }
    }
    unsigned long long* mrow = (unsigned long long*)(p.ws + OFF_MASK) + (size_t)(b * SEQ + t) * 64;
    mrow[lane] = mine;
  }
  __syncthreads();
}

DI void phase_select(const Params& p) {
  const int g = blockIdx.x, G = gridDim.x;
  const int tid = ltid(), wave = tid >> 6, lane = tid & 63;
  __shared__ __attribute__((aligned(16))) float red[8][64];
  for (int it = g * 8 + wave; it < NBATCH * NH; it += G * 8) {
    const int b = it >> 3, h = it & 7;
    const float* lf = (const float*)(p.ws + OFF_LF) + (size_t)b * SEQ * 8 + h;
    float* cs = (float*)(p.ws + OFF_CS) + (size_t)it * SEQ;
    float loc[64]; float run = 0.f;
#pragma unroll
    for (int i = 0; i < 64; ++i) { run += lf[(size_t)(lane * 64 + i) * 8]; loc[i] = run; }
    float incl = run;
#pragma unroll
    for (int o = 1; o < 64; o <<= 1) { const float t = __shfl_up(incl, o); if (lane >= o) incl += t; }
    const float base = incl - run;
#pragma unroll
    for (int i = 0; i < 64; ++i) cs[lane * 64 + i] = (base + loc[i]) * LOG2E;
  }
  for (int pr = g; pr < 256; pr += G) {
    const int item = pr * 2 + (wave >> 2);
    const int b = item >> 7, h = (item >> 4) & 7, n = item & 15;
    const u16* k = (const u16*)(p.ws + OFF_Q0 + 16 * MiB) + (size_t)(b * SEQ + n * 256 + (wave & 3) * 64) * 512 + h * 64 + lane;
    float s = 0.f;
    for (int i = 0; i < 64; ++i) s += bf2f(k[(size_t)i * 512]);
    red[wave][lane] = s;
    __syncthreads();
    if ((wave & 3) == 0) {
      const float tot = red[wave][lane] + red[wave + 1][lane] + red[wave + 2][lane] + red[wave + 3][lane];
      ((float*)(p.ws + OFF_KMEAN))[(size_t)item * 64 + lane] = tot * (1.f / 256.f);
    }
    __syncthreads();
  }
  for (int j = 0; j * G < 2048; ++j) {
    const int idx = j * G + ((j & 1) ? (G - 1 - g) : g);
    if (idx < 2048) {
      const int tg = 511 - (idx >> 2), b = idx & 3;
      select_item(p, b, tg * 8);
    }
  }
}

DI int perm23(int r) { return (r & ~12) | ((r & 4) << 1) | ((r & 8) >> 1); }

DI void attn_item(const Params& p, int br, int b, int h, int qb) {
  extern __shared__ __attribute__((aligned(16))) char smem[];
  u16* Ks = (u16*)smem;
  u16* Vs = (u16*)(smem + 2 * 64 * 144);
  float* cks = (float*)(smem + 4 * 64 * 144);
  const int tid = ltid(), wave = tid >> 6, lane = tid & 63, r = lane & 31, half = lane >> 5;
  const u16* Qp = (const u16*)(p.ws + OFF_Q0 + (size_t)br * 32 * MiB);
  const u16* Kp = (const u16*)(p.ws + OFF_Q0 + (size_t)br * 32 * MiB + 16 * MiB);
  const u16* VTp = (const u16*)(p.ws + OFF_VT0 + (size_t)br * 16 * MiB) + (size_t)(b * 8 + h) * 64 * SEQ;
  u16* Gp = (u16*)(p.ws + OFF_G0 + (size_t)br * 16 * MiB);
  const float* csrow = (const float*)(p.ws + OFF_CS) + (size_t)(b * 8 + h) * SEQ;
  const unsigned* maskp = (const unsigned*)(p.ws + OFF_MASK);
  const int qpos = qb * 256 + wave * 32 + r;
  const size_t qtok = (size_t)b * SEQ + qpos;

  bf16x8 qf[4];
#pragma unroll
  for (int ks = 0; ks < 4; ++ks) qf[ks] = *(const bf16x8*)(Qp + qtok * 512 + h * 64 + 16 * ks + 8 * half);

  unsigned selmask = 0u;
  if (br == 0 && qb > 0) {
    if (qb <= 3) selmask = (1u << qb) - 1u;
    else {
      const float* km = (const float*)(p.ws + OFF_KMEAN) + (size_t)(b * 8 + h) * 16 * 64;
      float qv[64];
      const u16* qrow = Qp + qtok * 512 + h * 64;
#pragma unroll
      for (int c8 = 0; c8 < 8; ++c8) {
        const u32x4 w = *(const u32x4*)(qrow + 8 * c8);
#pragma unroll
        for (int e = 0; e < 4; ++e) { qv[8 * c8 + 2 * e] = bf2f(w[e] & 0xffffu); qv[8 * c8 + 2 * e + 1] = bf2f(w[e] >> 16); }
      }
      float v0 = -INFINITY, v1 = -INFINITY, v2 = -INFINITY; int i0 = 0, i1 = 0, i2 = 0;
      for (int n = 0; n < qb; ++n) {
        float gsc = 0.f;
#pragma unroll
        for (int d = 0; d < 64; ++d) gsc = fmaf(qv[d], km[n * 64 + d], gsc);
        if (gsc > v0) { v2 = v1; i2 = i1; v1 = v0; i1 = i0; v0 = gsc; i0 = n; }
        else if (gsc > v1) { v2 = v1; i2 = i1; v1 = gsc; i1 = n; }
        else if (gsc > v2) { v2 = gsc; i2 = n; }
      }
      selmask = (1u << i0) | (1u << i1) | (1u << i2);
    }
  }
  const float cq = (br == 2) ? csrow[qpos] : 0.f;

  const int nkt = (qb + 1) * 4;
  const int my_last = qb * 4 + (wave >> 1);
  const int lrow = tid >> 3, lchunk = tid & 7;
  const u16* ksrc = Kp + ((size_t)b * SEQ + lrow) * 512 + h * 64 + lchunk * 8;
  const u16* vsrc = VTp + (size_t)lrow * SEQ + lchunk * 8;
  u32x4 kreg = *(const u32x4*)(ksrc);
  u32x4 vreg = *(const u32x4*)(vsrc);
  float creg = 0.f;
  if (br == 2 && tid < 64) creg = csrow[tid];
  __syncthreads();
  *(u32x4*)(Ks + lrow * 72 + lchunk * 8) = kreg;
  *(u32x4*)(Vs + lrow * 72 + lchunk * 8) = vreg;
  if (br == 2 && tid < 64) cks[tid] = creg;
  __syncthreads();

  f32x16 o0, o1;
#pragma unroll
  for (int i = 0; i < 16; ++i) { o0[i] = 0.f; o1[i] = 0.f; }
  float mrun = -1e30f, lrun = 0.f;
  const int kr = perm23(r);

  for (int kt = 0; kt < nkt; ++kt) {
    const int cur = kt & 1;
    const bool more = (kt + 1 < nkt);
    if (more) {
      kreg = *(const u32x4*)(ksrc + (size_t)(kt + 1) * 64 * 512);
      vreg = *(const u32x4*)(vsrc + (kt + 1) * 64);
      if (br == 2 && tid < 64) creg = csrow[(kt + 1) * 64 + tid];
    }
    if (kt <= my_last) {
      const u16* Kb = Ks + cur * 64 * 72;
      const u16* Vb = Vs + cur * 64 * 72;
      f32x16 s0, s1;
#pragma unroll
      for (int i = 0; i < 16; ++i) { s0[i] = 0.f; s1[i] = 0.f; }
#pragma unroll
      for (int ks = 0; ks < 4; ++ks) {
        const bf16x8 k0 = *(const bf16x8*)(Kb + (kr) * 72 + 16 * ks + 8 * half);
        const bf16x8 k1 = *(const bf16x8*)(Kb + (32 + kr) * 72 + 16 * ks + 8 * half);
        s0 = __builtin_amdgcn_mfma_f32_32x32x16_bf16(k0, qf[ks], s0, 0, 0, 0);
        s1 = __builtin_amdgcn_mfma_f32_32x32x16_bf16(k1, qf[ks], s1, 0, 0, 0);
      }
      if (br == 2) {
        const float* cb = cks + cur * 64;
#pragma unroll
        for (int i = 0; i < 16; ++i) {
          const int ko = (i & 7) + 8 * half + 16 * (i >> 3);
          s0[i] += cq - cb[ko];
          s1[i] += cq - cb[32 + ko];
        }
      }
      bool lane_on = true;
      const bool diag = (kt >= qb * 4);
      if (br == 1 || diag) {
        unsigned w0, w1;
        if (br == 1) {
          const u32x2 mw = *(const u32x2*)(maskp + qtok * 128 + 2 * kt);
          w0 = mw[0]; w1 = mw[1];
        } else {
          const int nv0 = qpos - 64 * kt + 1, nv1 = nv0 - 32;
          w0 = nv0 >= 32 ? 0xffffffffu : (nv0 <= 0 ? 0u : ((1u << nv0) - 1u));
          w1 = nv1 >= 32 ? 0xffffffffu : (nv1 <= 0 ? 0u : ((1u << nv1) - 1u));
        }
        w0 >>= (8 * half); w1 >>= (8 * half);
#pragma unroll
        for (int i = 0; i < 16; ++i) {
          const int bitp = (i & 7) + 16 * (i >> 3);
          s0[i] = ((w0 >> bitp) & 1u) ? s0[i] : -INFINITY;
          s1[i] = ((w1 >> bitp) & 1u) ? s1[i] : -INFINITY;
        }
      } else if (br == 0) {
        lane_on = (selmask >> (kt >> 2)) & 1u;
      }
      float tmax = -INFINITY;
#pragma unroll
      for (int i = 0; i < 16; ++i) tmax = fmaxf(tmax, fmaxf(s0[i], s1[i]));
      tmax = fmaxf(tmax, __shfl_xor(tmax, 32));
      if (!lane_on) tmax = -INFINITY;
      const float mnew = fmaxf(mrun, tmax);
      const float alpha = fast_exp2(mrun - mnew);
      mrun = mnew;
      const float sub = lane_on ? mnew : INFINITY;
      float psum = 0.f;
#pragma unroll
      for (int i = 0; i < 16; ++i) { s0[i] = fast_exp2(s0[i] - sub); s1[i] = fast_exp2(s1[i] - sub); psum += s0[i] + s1[i]; }
      lrun = lrun * alpha + psum;
      if (__ballot(alpha != 1.f) != 0ull) {
#pragma unroll
        for (int i = 0; i < 16; ++i) { o0[i] *= alpha; o1[i] *= alpha; }
      }
      bf16x8 pf[4];
      {
        u32x4 t;
        t[0] = pk2(s0[0], s0[1]); t[1] = pk2(s0[2], s0[3]); t[2] = pk2(s0[4], s0[5]); t[3] = pk2(s0[6], s0[7]); pf[0] = __builtin_bit_cast(bf16x8, t);
        t[0] = pk2(s0[8], s0[9]); t[1] = pk2(s0[10], s0[11]); t[2] = pk2(s0[12], s0[13]); t[3] = pk2(s0[14], s0[15]); pf[1] = __builtin_bit_cast(bf16x8, t);
        t[0] = pk2(s1[0], s1[1]); t[1] = pk2(s1[2], s1[3]); t[2] = pk2(s1[4], s1[5]); t[3] = pk2(s1[6], s1[7]); pf[2] = __builtin_bit_cast(bf16x8, t);
        t[0] = pk2(s1[8], s1[9]); t[1] = pk2(s1[10], s1[11]); t[2] = pk2(s1[12], s1[13]); t[3] = pk2(s1[14], s1[15]); pf[3] = __builtin_bit_cast(bf16x8, t);
      }
#pragma unroll
      for (int kk = 0; kk < 4; ++kk) {
        const bf16x8 va = *(const bf16x8*)(Vb + (r) * 72 + 16 * kk + 8 * half);
        const bf16x8 vb = *(const bf16x8*)(Vb + (32 + r) * 72 + 16 * kk + 8 * half);
        o0 = __builtin_amdgcn_mfma_f32_32x32x16_bf16(va, pf[kk], o0, 0, 0, 0);
        o1 = __builtin_amdgcn_mfma_f32_32x32x16_bf16(vb, pf[kk], o1, 0, 0, 0);
      }
    }
    if (more) {
      const int nx = cur ^ 1;
      *(u32x4*)(Ks + nx * 64 * 72 + lrow * 72 + lchunk * 8) = kreg;
      *(u32x4*)(Vs + nx * 64 * 72 + lrow * 72 + lchunk * 8) = vreg;
      if (br == 2 && tid < 64) cks[nx * 64 + tid] = creg;
    }
    __syncthreads();
  }
  const float ltot = lrun + __shfl_xor(lrun, 32);
  const float inv = 1.f / ltot;
  u16* grow = Gp + qtok * 512 + h * 64;
#pragma unroll
  for (int db = 0; db < 2; ++db)
#pragma unroll
    for (int g4 = 0; g4 < 4; ++g4) {
      const int d0 = 32 * db + 8 * g4 + 4 * half;
      const u32x2 gw = *(const u32x2*)(grow + d0);
      float a[4];
#pragma unroll
      for (int e = 0; e < 4; ++e) a[e] = (db == 0 ? o0[4 * g4 + e] : o1[4 * g4 + e]) * inv;
      u32x2 ow;
      ow[0] = pk2(a[0] * bf2f(gw[0] & 0xffffu), a[1] * bf2f(gw[0] >> 16));
      ow[1] = pk2(a[2] * bf2f(gw[1] & 0xffffu), a[3] * bf2f(gw[1] >> 16));
      *(u32x2*)(grow + d0) = ow;
    }
}

DI void phase_attn(const Params& p) {
  const int g = blockIdx.x, G = gridDim.x;
  constexpr int NI = 3 * NBATCH * NH * 16;
  for (int j = 0; j * G < NI; ++j) {
    const int idx = j * G + ((j & 1) ? (G - 1 - g) : g);
    if (idx < NI) {
      const int qb = 15 - idx / 96, rem = idx % 96;
      const int br = rem % 3, bh = rem / 3;
      attn_item(p, br, bh >> 3, bh & 7, qb);
    }
  }
}

DI void phase_merge(const Params& p) {
  const u16* xb = (const u16*)(p.ws + OFF_XB);
  const u16* wm_t = (const u16*)(p.ws + OFF_WIN) + (size_t)N1 * DM;
  const u16* wbr_t = (const u16*)(p.ws + OFF_WBR);
  const float* rstd = (const float*)(p.ws + OFF_RSTD);
  u16* merged = (u16*)(p.ws + OFF_MERGED);
  char* scr = p.ws + OFF_SCR + (size_t)blockIdx.x * 384 * 1024;
  u32x2* sig = (u32x2*)scr;
  f32x4* part = (f32x4*)(scr + 128 * 1024);
  const int tid = ltid();
  for (int u = blockIdx.x; u < 256; u += gridDim.x) {
    const int pn = u / 64, pm = u % 64;
    const int brow = pm * 256, bcol = pn * 256;
    for (int nb = 0; nb < 3; ++nb) {
      gemm_unit(xb, DM, wm_t + (size_t)nb * DM * DM, DM, DM, brow, bcol,
        [&](int ai, int bj, int m, int n, f32x4 a, int row0, int col) {
          float v[4];
#pragma unroll
          for (int j = 0; j < 4; ++j) { const float z = a[j] * rstd[row0 + j]; v[j] = 1.f / (1.f + __expf(-z)); }
          u32x2 o; o[0] = pk2(v[0], v[1]); o[1] = pk2(v[2], v[3]);
          int t_ = tid; asm volatile("" : "+v"(t_));
          sig[(((ai * 2 + bj) * 4 + m) * 2 + n) * 512 + t_] = o;
        });
      const u16* gp = (const u16*)(p.ws + OFF_G0 + (size_t)nb * 16 * MiB);
      gemm_unit(gp, WID, wbr_t + (size_t)nb * DM * WID, WID, WID, brow, bcol,
        [&](int ai, int bj, int m, int n, f32x4 a, int row0, int col) {
          int t_ = tid; asm volatile("" : "+v"(t_));
          const int slot = (((ai * 2 + bj) * 4 + m) * 2 + n) * 512 + t_;
          const u32x2 sg = sig[slot];
          f32x4 v;
          v[0] = a[0] * bf2f(sg[0] & 0xffffu); v[1] = a[1] * bf2f(sg[0] >> 16);
          v[2] = a[2] * bf2f(sg[1] & 0xffffu); v[3] = a[3] * bf2f(sg[1] >> 16);
          if (nb > 0) { const f32x4 pv = part[slot]; v += pv; }
          if (nb < 2) part[slot] = v;
          else {
#pragma unroll
            for (int j = 0; j < 4; ++j) merged[(size_t)(row0 + j) * DM + col] = f2bf(v[j]);
          }
        });
    }
  }
}

DI void phase_out(const Params& p, int layer) {
  const u16* merged = (const u16*)(p.ws + OFF_MERGED);
  const u16* wout_t = (const u16*)(p.ws + OFF_WOUT);
  const float* resid = layer == 0 ? p.x : p.out;
  float* out = p.out;
  for (int u = blockIdx.x; u < 256; u += gridDim.x) {
    const int pn = u / 64, pm = u % 64;
    gemm_unit(merged, DM, wout_t, DM, DM, pm * 256, pn * 256,
      [&](int ai, int bj, int m, int n, f32x4 a, int row0, int col) {
#pragma unroll
        for (int j = 0; j < 4; ++j) { const size_t o = (size_t)(row0 + j) * DM + col; out[o] = resid[o] + a[j]; }
      });
  }
}

DI void phase_final(const Params& p) {
  const int tid_ = ltid(), wave = tid_ >> 6, lane = tid_ & 63;
  const float4* g4 = (const float4*)p.final_gain;
  for (int row = blockIdx.x * 8 + wave; row < T_TOK; row += gridDim.x * 8) {
    float4* s4 = (float4*)(p.out + (size_t)row * DM);
    float4 v[4]; float ss = 0.f;
#pragma unroll
    for (int i = 0; i < 4; ++i) { v[i] = s4[lane + 64 * i]; ss += v[i].x * v[i].x + v[i].y * v[i].y + v[i].z * v[i].z + v[i].w * v[i].w; }
    ss = wave_sum(ss);
    const float rs = rsqrtf(ss * (1.0f / DM) + 1e-6f);
#pragma unroll
    for (int i = 0; i < 4; ++i) {
      const float4 gg = g4[lane + 64 * i];
      float4 o; o.x = v[i].x * rs * gg.x; o.y = v[i].y * rs * gg.y; o.z = v[i].z * rs * gg.z; o.w = v[i].w * rs * gg.w;
      s4[lane + 64 * i] = o;
    }
  }
}


#define XB_TMO      128
#define XB_XCNT(j)  (256  + 64 * (j))
#define XB_XSUB(j)  (1280 + 64 * (j))
#define XB_XGEN(j)  (2304 + 64 * (j))
#define XB_TOP      3328
#define XB_TOPGEN   3392
#define XCD_BAR_WORDS 3456
#define XB_SPIN_CAP (1u << 22)
#define LAS __attribute__((address_space(3)))
DI unsigned xb_ld(unsigned* p)              { return __hip_atomic_load(p, __ATOMIC_RELAXED, __HIP_MEMORY_SCOPE_AGENT); }
DI unsigned xb_add(unsigned* p, unsigned v) { return __hip_atomic_fetch_add(p, v, __ATOMIC_RELAXED, __HIP_MEMORY_SCOPE_AGENT); }
DI unsigned xb_xcc_id() { return (unsigned)__builtin_amdgcn_s_getreg((3 << 11) | 20) & 0xFu; }
#define XB_SPIN(cond, bar) do { unsigned _sp = 0; while (cond) { __builtin_amdgcn_s_sleep(1); \
    if ((++_sp & 255u) == 0u) { if (xb_ld(&(bar)[XB_TMO])) break; if (_sp > XB_SPIN_CAP) { atomicAdd(&(bar)[XB_TMO], 1u); break; } } } } while (0)
struct XcdBarrier { unsigned* bar; unsigned x; volatile LAS unsigned* st; };
DI XcdBarrier xcd_barrier_post(unsigned* bar, volatile LAS unsigned* st) {
  XcdBarrier b; b.bar = bar; b.x = xb_xcc_id(); b.st = st;
  if (threadIdx.x == 0) (void)xb_add(&bar[XB_XCNT(b.x)], 1u);
  return b;
}
DI void xcd_barrier_complete(unsigned* bar, unsigned x, unsigned& nloc, unsigned& nx) {
  const unsigned G = gridDim.x * gridDim.y * gridDim.z;
  unsigned sum, cnt, mine, sp = 0u;
  for (;;) {
    sum = 0u; cnt = 0u; mine = 0u;
#pragma unroll
    for (unsigned j = 0; j < 16; ++j) { const unsigned c = xb_ld(&bar[XB_XCNT(j)]); sum += c; cnt += (c > 0u) ? 1u : 0u; mine = (j == x) ? c : mine; }
    if (sum == G) break;
    __builtin_amdgcn_s_sleep(1);
    if ((++sp & 255u) == 0u) { if (xb_ld(&bar[XB_TMO])) break; if (sp > XB_SPIN_CAP) { atomicAdd(&bar[XB_TMO], 1u); break; } }
  }
  nloc = mine > 0u ? mine : 1u; nx = cnt > 0u ? cnt : 1u;
}
DI void xcd_barrier(const XcdBarrier& b) {
  asm volatile("s_waitcnt vmcnt(0)" ::: "memory");
  __syncthreads();
  if (threadIdx.x == 0) {
    unsigned* bar = b.bar;
    __builtin_amdgcn_s_waitcnt(0);
    unsigned nloc = b.st[0], nx = b.st[1];
    if (nloc == 0u) { xcd_barrier_complete(bar, b.x, nloc, nx); b.st[0] = nloc; b.st[1] = nx; }
    const unsigned old = xb_add(&bar[XB_XSUB(b.x)], 1u);
    const unsigned gen = old / nloc;
    if (old + 1u == (gen + 1u) * nloc) {
      __builtin_amdgcn_fence(__ATOMIC_RELEASE, "agent");
      asm volatile("s_waitcnt vmcnt(0)" ::: "memory");
      const unsigned og = xb_add(&bar[XB_TOP], 1u);
      const unsigned tg = og / nx;
      if (og + 1u == (tg + 1u) * nx) xb_add(&bar[XB_TOPGEN], 1u);
      else XB_SPIN(xb_ld(&bar[XB_TOPGEN]) == tg, bar);
      __builtin_amdgcn_fence(__ATOMIC_ACQUIRE, "agent");
      xb_add(&bar[XB_XGEN(b.x)], 1u);
      asm volatile("s_waitcnt vmcnt(0)" ::: "memory");
    } else {
      XB_SPIN(xb_ld(&bar[XB_XGEN(b.x)]) == gen, bar);
      __builtin_amdgcn_fence(__ATOMIC_ACQUIRE, "agent");
      asm volatile("s_waitcnt vmcnt(0)" ::: "memory");
    }
  }
  __syncthreads();
}

__global__ void __launch_bounds__(NTHR) mega(Params p, int ph_lo, int ph_hi) {
  cg::grid_group grid = cg::this_grid();
  __shared__ uint4 xb_words;
  if (threadIdx.x == 0) xb_words = make_uint4(0u, 0u, 0u, 0u);
  __syncthreads();
  XcdBarrier xb = xcd_barrier_post((unsigned*)(p.ws + OFF_BAR), (volatile LAS unsigned*)&xb_words);
  for (int ph = ph_lo; ph < ph_hi; ++ph) {
    if (ph == 12) phase_final(p);
    else {
      const int layer = ph / 6, k = ph % 6;
      if (k == 0) phase_prep(p, layer);
      else if (k == 1) phase_proj(p, layer);
      else if (k == 2) phase_select(p);
      else if (k == 3) phase_attn(p);
      else if (k == 4) phase_merge(p);
      else phase_out(p, layer);
    }
    if (ph + 1 < ph_hi) {
      if (ph == ph_lo) grid.sync();
      else xcd_barrier(xb);
    }
  }
}

extern "C" void kernel_launch(void* const* d_in, const int* in_sizes, int n_in, void* d_out, int out_size,
                              void* d_ws, size_t ws_size, hipStream_t stream) {
  if (ws_size < WS_NEED) { fprintf(stderr, "workspace too small: %zu < %zu\n", ws_size, (size_t)WS_NEED); return; }
  Params p{};
  p.x = (const float*)d_in[0]; p.norm_gain = (const float*)d_in[1]; p.w_in = (const float*)d_in[2];
  p.fbias = (const float*)d_in[3]; p.w_branch = (const float*)d_in[4]; p.w_out = (const float*)d_in[5];
  p.final_gain = (const float*)d_in[6];
  p.out = (float*)d_out; p.ws = (char*)d_ws;
  (void)hipFuncSetAttribute((const void*)mega, hipFuncAttributeMaxDynamicSharedMemorySize, SMEM_BYTES);
  static int grid = 0;
  if (!grid) {
    int dev = 0, cus = 0, per_cu = 0;
    hipGetDevice(&dev);
    hipDeviceGetAttribute(&cus, hipDeviceAttributeMultiprocessorCount, dev);
    hipOccupancyMaxActiveBlocksPerMultiprocessor(&per_cu, (const void*)mega, NTHR, SMEM_BYTES);
    if (per_cu < 1) per_cu = 1;
    grid = cus;
    if (grid > 256) grid = 256;
  }
  (void)hipMemsetAsync((char*)d_ws + OFF_BAR, 0, 16384, stream);
  int lo = 0, hi = 13;
  void* args[] = {&p, &lo, &hi};
  hipError_t e = hipLaunchCooperativeKernel((const void*)mega, dim3(grid), dim3(NTHR), args, SMEM_BYTES, stream);
  if (e != hipSuccess) fprintf(stderr, "cooperative launch failed: %s (grid %d)\n", hipGetErrorString(e), grid);
}
```

```cpp
#include <hip/hip_runtime.h>
#include <hip/hip_bf16.h>
#include <hip/hip_cooperative_groups.h>
#include <cstdio>
#include <cstdint>
namespace cg = cooperative_groups;

typedef unsigned short u16;
using bf16x8 = __attribute__((ext_vector_type(8))) short;
using f32x4  = __attribute__((ext_vector_type(4))) float;
using f32x16 = __attribute__((ext_vector_type(16))) float;
using u32x2  = __attribute__((ext_vector_type(2))) unsigned;
using u32x4  = __attribute__((ext_vector_type(4))) unsigned;
#define DI __device__ __forceinline__

constexpr int T_TOK = 16384, SEQ = 4096, NBATCH = 4, DM = 1024, NH = 8, HD = 64, WID = 512;
constexpr int D_IN = 9808;
constexpr int N1 = 6912;
constexpr int N1_VALID = 6736;
constexpr int NMERGE = 3072;
constexpr int NWROWS = N1 + NMERGE;
constexpr float QSCALE = 0.125f * 1.4426950408889634f;
constexpr float LOG2E = 1.4426950408889634f;
constexpr int NTHR = 512;
constexpr int SMEM_BYTES = 8 * 4128 * 4;

constexpr size_t MiB = 1024 * 1024;
constexpr size_t OFF_BAR = 0;
constexpr size_t OFF_ROPE = 16384;
constexpr size_t OFF_RSTD = OFF_ROPE + 262144;
constexpr size_t OFF_WI = OFF_RSTD + 65536;
constexpr size_t OFF_LF = OFF_WI + 524288;
constexpr size_t OFF_CS = OFF_LF + 524288;
constexpr size_t OFF_KMEAN = OFF_CS + 524288;
constexpr size_t OFF_XB = 2 * MiB;
constexpr size_t OFF_WIN = 34 * MiB;
constexpr size_t OFF_WBR = 54 * MiB;
constexpr size_t OFF_WOUT = 57 * MiB;
constexpr size_t OFF_MASK = 59 * MiB;
constexpr size_t OFF_KI = 67 * MiB;
constexpr size_t OFF_QI = 69 * MiB;
constexpr size_t OFF_Q0 = 85 * MiB;
constexpr size_t OFF_VT0 = 181 * MiB;
constexpr size_t OFF_G0 = 229 * MiB;
constexpr size_t WS_NEED = 277 * MiB;
constexpr size_t OFF_MERGED = OFF_Q0;
constexpr size_t OFF_SCR = 117 * MiB;

struct Params {
  const float* x; const float* norm_gain; const float* w_in; const float* fbias;
  const float* w_branch; const float* w_out; const float* final_gain;
  float* out; char* ws;
};

DI unsigned pk2(float a, float b) {
  typedef __bf16 bf2 __attribute__((ext_vector_type(2)));
  typedef float f2 __attribute__((ext_vector_type(2)));
  f2 v = {a, b};
  bf2 r = __builtin_convertvector(v, bf2);
  return __builtin_bit_cast(unsigned, r);
}
DI u16 f2bf(float a) { return (u16)(pk2(a, 0.f) & 0xffffu); }
DI float bf2f(unsigned v) { return __uint_as_float(v << 16); }
DI float wave_sum(float v) {
#pragma unroll
  for (int o = 32; o > 0; o >>= 1) v += __shfl_xor(v, o);
  return v;
}
DI int wave_sum_i(int v) {
#pragma unroll
  for (int o = 32; o > 0; o >>= 1) v += __shfl_xor(v, o);
  return v;
}
DI int ltid() { int t = threadIdx.x; asm volatile("" : "+v"(t)); return t; }
DI float fast_exp2(float x) { return __builtin_amdgcn_exp2f(x); }

DI void tr_tile(const float* __restrict__ src, int src_ld, int k0, int n0, int mode, u16* __restrict__ dst, int dst_ld,
                const float* __restrict__ gain, float* lds) {
  const int tid = ltid();
  {
    const int tx = tid & 63, ty = tid >> 6;
    const int n = n0 + tx;
    int c = n;
    if (mode == 1) c = (n < N1_VALID) ? n : (n >= N1 ? n - (N1 - N1_VALID) : -1);
#pragma unroll
    for (int i = 0; i < 8; ++i) {
      const int kk = ty + 8 * i;
      const int k = k0 + kk;
      float v = 0.f;
      if (c >= 0) v = src[(size_t)k * src_ld + c];
      if (gain) v *= gain[k];
      lds[kk * 65 + tx] = v;
    }
  }
  __syncthreads();
  {
    const int kx = (tid & 31) * 2, ny = tid >> 5;
#pragma unroll
    for (int i = 0; i < 4; ++i) {
      const int nn = ny + 16 * i;
      const unsigned pv = pk2(lds[kx * 65 + nn], lds[(kx + 1) * 65 + nn]);
      *(unsigned*)(dst + (size_t)(n0 + nn) * dst_ld + k0 + kx) = pv;
    }
  }
  __syncthreads();
}

DI void phase_prep(const Params& p, int layer) {
  extern __shared__ __attribute__((aligned(16))) char smem[];
  float* lds = (float*)smem;
  const int tid = ltid(), wave = tid >> 6, lane = tid & 63;
  const int G = gridDim.x, g = blockIdx.x;
  if (layer == 0) {
    float2* rope = (float2*)(p.ws + OFF_ROPE);
    for (int e = g * NTHR + tid; e < SEQ * 8; e += G * NTHR) {
      const int pos = e >> 3, i = e & 7;
      const float invf = i == 0 ? 1.0f : i == 1 ? 0.1939227432012558f : i == 2 ? 0.03760603070259094f : i == 3 ? 0.007292664609849453f
                       : i == 4 ? 0.0014142135623842478f : i == 5 ? 0.00027424818836152554f : i == 6 ? 5.3182957344688475e-05f : 1.0313385246263351e-05f;
      const float ang = (float)pos * invf;
      const float kf = rintf(ang * 0.6366197723675814f);
      const int kq = (int)kf;
      float rr = fmaf(kf, -1.5703125f, ang);
      rr = fmaf(kf, -4.837512969970703125e-4f, rr);
      rr = fmaf(kf, -7.54978995489188216e-8f, rr);
      const float r2 = rr * rr;
      float ks3 = -1.9515295891e-4f, kc3 = 2.443315711809948e-5f;
      asm volatile("" : "+v"(ks3), "+v"(kc3));
      const float sp = fmaf(rr * r2, fmaf(r2, fmaf(r2, ks3, 8.3321608736e-3f), -1.6666654611e-1f), rr);
      const float cp = fmaf(r2 * r2, fmaf(r2, fmaf(r2, kc3, -1.388731625493765e-3f), 4.166664568298827e-2f), fmaf(r2, -0.5f, 1.0f));
      float sn, cs;
      if ((kq & 3) == 0) { sn = sp; cs = cp; } else if ((kq & 3) == 1) { sn = cp; cs = -sp; } else if ((kq & 3) == 2) { sn = -sp; cs = -cp; } else { sn = -cp; cs = sp; }
      rope[e] = make_float2(cs, sn);
    }
  }
  {
    const float* src = layer == 0 ? p.x : p.out;
    u16* xb = (u16*)(p.ws + OFF_XB);
    float* rstd = (float*)(p.ws + OFF_RSTD);
    for (int row = g * 8 + wave; row < T_TOK; row += G * 8) {
      const float4* s4 = (const float4*)(src + (size_t)row * DM);
      float ss = 0.f;
      float4 v[4];
#pragma unroll
      for (int i = 0; i < 4; ++i) { v[i] = s4[lane + 64 * i]; ss += v[i].x * v[i].x + v[i].y * v[i].y + v[i].z * v[i].z + v[i].w * v[i].w; }
      ss = wave_sum(ss);
#pragma unroll
      for (int i = 0; i < 4; ++i) {
        u32x2 o; o[0] = pk2(v[i].x, v[i].y); o[1] = pk2(v[i].z, v[i].w);
        *(u32x2*)(xb + (size_t)row * DM + (lane + 64 * i) * 4) = o;
      }
      if (lane == 0) rstd[row] = rsqrtf(ss * (1.0f / DM) + 1e-6f);
    }
  }
  {
    const float* w_in = p.w_in + (size_t)layer * DM * D_IN;
    const float* gain = p.norm_gain + (size_t)layer * DM;
    const float* w_br = p.w_branch + (size_t)layer * 3 * WID * DM;
    const float* w_out = p.w_out + (size_t)layer * DM * DM;
    u16* win_t = (u16*)(p.ws + OFF_WIN);
    u16* wbr_t = (u16*)(p.ws + OFF_WBR);
    u16* wout_t = (u16*)(p.ws + OFF_WOUT);
    constexpr int NT_IN = 16 * (NWROWS / 64);
    constexpr int NT_BR = 3 * 8 * 16;
    constexpr int NT_OUT = 16 * 16;
    for (int t = g; t < NT_IN + NT_BR + NT_OUT; t += G) {
      if (t < NT_IN) {
        const int kt = t & 15, nt = t >> 4;
        tr_tile(w_in, D_IN, kt * 64, nt * 64, 1, win_t, DM, gain, lds);
      } else if (t < NT_IN + NT_BR) {
        const int u = t - NT_IN; const int nb = u / 128, r = u % 128; const int kt = r & 7, nt = r >> 3;
        tr_tile(w_br + (size_t)nb * WID * DM, DM, kt * 64, nt * 64, 0, wbr_t + (size_t)nb * DM * WID, WID, nullptr, lds);
      } else {
        const int u = t - NT_IN - NT_BR; const int kt = u & 15, nt = u >> 4;
        tr_tile(w_out, DM, kt * 64, nt * 64, 0, wout_t, DM, nullptr, lds);
      }
    }
  }
}

constexpr int G_BK = 64, G_HALF = 128, G_HT = G_HALF * G_BK;
DI int lds_byte(int r, int c) {
  int st = (r >> 4) * 2 + (c >> 5), rr = r & 15, cc = c & 31, ob = rr * 64 + cc * 2;
  return st * 1024 + (ob ^ (((ob >> 9) & 1) << 5));
}
DI void stage_rc(int b, int& R, int& C) {
  int st = b / 1024, sb = b % 1024, swz = sb ^ (((sb >> 9) & 1) << 5);
  R = (st >> 1) * 16 + swz / 64; C = (st & 1) * 32 + (swz % 64) / 2;
}

template <class Epi>
DI void gemm_unit(const u16* __restrict__ A, int lda, const u16* __restrict__ Bt, int ldb, int K, int brow, int bcol, Epi&& epi) {
  extern __shared__ __attribute__((aligned(16))) char smem[];
  u16* shm = (u16*)smem;
#define SA(b, h) (shm + ((b) * 2 + (h)) * G_HT)
#define SB(b, h) (shm + (4 + (b) * 2 + (h)) * G_HT)
#define STAGE_(P, BASE, LD, br, kt, _o0, _o1) do { const char* _gp = (const char*)((BASE) + ((size_t)(br) * (LD) + (size_t)(kt) * G_BK)); \
    __builtin_amdgcn_global_load_lds((const unsigned*)(_gp + (size_t)(_o0)), \
        (__attribute__((address_space(3))) unsigned*)((char*)(P) + tidl * 16), 16, 0, 0); \
    __builtin_amdgcn_global_load_lds((const unsigned*)(_gp + (size_t)(_o1)), \
        (__attribute__((address_space(3))) unsigned*)((char*)(P) + tidl * 16 + 8192), 16, 0, 0); } while (0)
#define STAGE(P, BASE, LD, br, kt) STAGE_SEL_##BASE(P, LD, br, kt)
#define STAGE_SEL_A(P, LD, br, kt) STAGE_(P, A, LD, br, kt, offA0, offA1)
#define STAGE_SEL_Bt(P, LD, br, kt) STAGE_(P, Bt, LD, br, kt, offB0, offB1)
#define LDA(dst, b, h) for (int m = 0; m < 4; ++m) for (int k = 0; k < 2; ++k) \
    dst[m][k] = *reinterpret_cast<const bf16x8*>((char*)SA(b, h) + lds_byte(wr * 64 + m * 16 + fr, k * 32 + fq * 8))
#define LDB(dst, b, h) for (int n = 0; n < 2; ++n) for (int k = 0; k < 2; ++k) \
    dst[n][k] = *reinterpret_cast<const bf16x8*>((char*)SB(b, h) + lds_byte(wc * 32 + n * 16 + fr, k * 32 + fq * 8))
#define MMA(ai, bj, At, Bt_) do { __builtin_amdgcn_s_setprio(1); \
    for (int m = 0; m < 4; ++m) for (int n = 0; n < 2; ++n) for (int k = 0; k < 2; ++k) \
      acc[ai][bj][m][n] = __builtin_amdgcn_mfma_f32_16x16x32_bf16(At[m][k], Bt_[n][k], acc[ai][bj][m][n], 0, 0, 0); \
    __builtin_amdgcn_s_setprio(0); } while (0)
#define WAIT_V(n) asm volatile("s_waitcnt vmcnt(" #n ")" ::: "memory")
#define WAIT_L(n) asm volatile("s_waitcnt lgkmcnt(" #n ")" ::: "memory")
#define BAR __builtin_amdgcn_s_barrier()
#define SCHED __builtin_amdgcn_sched_barrier(0)
  int tidl = threadIdx.x; asm volatile("" : "+v"(tidl));
  const int wid = __builtin_amdgcn_readfirstlane(tidl >> 6), lane = tidl & 63, wr = wid >> 2, wc = wid & 3, fr = lane & 15, fq = lane >> 4;
  f32x4 acc[2][2][4][2] = {};
  bf16x8 At[4][2], B0[2][2], B1[2][2];
  const int nt = K / G_BK;
  unsigned offA0, offA1, offB0, offB1;
  { int _r, _c; stage_rc(tidl * 16, _r, _c); offA0 = (unsigned)(_r * lda + _c) * 2u; offB0 = (unsigned)(_r * ldb + _c) * 2u;
    stage_rc(tidl * 16 + 8192, _r, _c); offA1 = (unsigned)(_r * lda + _c) * 2u; offB1 = (unsigned)(_r * ldb + _c) * 2u; }
  STAGE(SB(0, 0), Bt, ldb, bcol, 0); STAGE(SA(0, 0), A, lda, brow, 0);
  STAGE(SB(0, 1), Bt, ldb, bcol + G_HALF, 0); STAGE(SA(0, 1), A, lda, brow + G_HALF, 0);
  if (wr == 1) BAR;
  WAIT_V(4); BAR;
  STAGE(SB(1, 0), Bt, ldb, bcol, 1); STAGE(SA(1, 0), A, lda, brow, 1); STAGE(SB(1, 1), Bt, ldb, bcol + G_HALF, 1);
  WAIT_V(6); BAR;
  for (int t = 0; t < nt - 2; t += 2) {
    LDB(B0, 0, 0); SCHED; LDA(At, 0, 0); STAGE(SA(1, 1), A, lda, brow + G_HALF, t + 1);
    WAIT_L(8); BAR; WAIT_L(0); MMA(0, 0, At, B0); BAR; SCHED;
    LDB(B1, 0, 1); STAGE(SB(0, 0), Bt, ldb, bcol, t + 2);
    BAR; WAIT_L(0); MMA(0, 1, At, B1); BAR;
    LDA(At, 0, 1); STAGE(SA(0, 0), A, lda, brow, t + 2);
    BAR; WAIT_L(0); MMA(1, 0, At, B0); BAR; SCHED;
    STAGE(SB(0, 1), Bt, ldb, bcol + G_HALF, t + 2);
    WAIT_V(6); BAR; MMA(1, 1, At, B1); BAR;
    LDB(B0, 1, 0); SCHED; LDA(At, 1, 0); STAGE(SA(0, 1), A, lda, brow + G_HALF, t + 2);
    WAIT_L(8); BAR; WAIT_L(0); MMA(0, 0, At, B0); BAR; SCHED;
    LDB(B1, 1, 1); STAGE(SB(1, 0), Bt, ldb, bcol, t + 3);
    BAR; WAIT_L(0); MMA(0, 1, At, B1); BAR;
    LDA(At, 1, 1); STAGE(SA(1, 0), A, lda, brow, t + 3);
    BAR; WAIT_L(0); MMA(1, 0, At, B0); BAR; SCHED;
    STAGE(SB(1, 1), Bt, ldb, bcol + G_HALF, t + 3);
    WAIT_V(6); BAR; MMA(1, 1, At, B1); BAR;
  }
  { LDB(B0, 0, 0); LDA(At, 0, 0); STAGE(SA(1, 1), A, lda, brow + G_HALF, nt - 1);
    BAR; WAIT_L(0); MMA(0, 0, At, B0); BAR;
    LDB(B1, 0, 1); BAR; WAIT_L(0); MMA(0, 1, At, B1); BAR;
    LDA(At, 0, 1); WAIT_V(4); BAR; WAIT_L(0); MMA(1, 0, At, B0); MMA(1, 1, At, B1); BAR; }
  { LDB(B0, 1, 0); LDA(At, 1, 0); WAIT_V(2); BAR; WAIT_L(0); MMA(0, 0, At, B0); BAR;
    LDB(B1, 1, 1); WAIT_V(0); BAR; WAIT_L(0); MMA(0, 1, At, B1); BAR;
    LDA(At, 1, 1); BAR; WAIT_L(0); MMA(1, 0, At, B0); MMA(1, 1, At, B1); BAR; }
  if (wr == 0) BAR;
#define EPI1(ai, bj, m, n) { int _r0 = brow + ai * 128 + wr * 64 + m * 16 + fq * 4, _c0 = bcol + bj * 128 + wc * 32 + n * 16 + fr; asm volatile("" : "+v"(_r0), "+v"(_c0)); epi(ai, bj, m, n, acc[ai][bj][m][n], _r0, _c0); SCHED; }
#define EPI4(ai, bj) EPI1(ai, bj, 0, 0) EPI1(ai, bj, 0, 1) EPI1(ai, bj, 1, 0) EPI1(ai, bj, 1, 1) EPI1(ai, bj, 2, 0) EPI1(ai, bj, 2, 1) EPI1(ai, bj, 3, 0) EPI1(ai, bj, 3, 1)
  EPI4(0, 0) EPI4(0, 1) EPI4(1, 0) EPI4(1, 1)
#undef EPI1
#undef EPI4
#undef SA
#undef SB
#undef STAGE
#undef STAGE_
#undef STAGE_SEL_A
#undef STAGE_SEL_Bt
#undef LDA
#undef LDB
#undef MMA
}

DI void phase_proj(const Params& p, int layer) {
  const u16* xb = (const u16*)(p.ws + OFF_XB);
  const u16* win_t = (const u16*)(p.ws + OFF_WIN);
  const float* rstd = (const float*)(p.ws + OFF_RSTD);
  const float2* rope = (const float2*)(p.ws + OFF_ROPE);
  const float* fb = p.fbias + layer * 8;
  const int tid_ = ltid(), lane = tid_ & 63, wid = tid_ >> 6, wc = wid & 3, fr = lane & 15;
  constexpr int NU = 64 * 27;
  for (int u = blockIdx.x; u < NU; u += gridDim.x) {
    const int pn = u / 64, pm = u % 64;
    const int brow = pm * 256, bcol = pn * 256;
    char* ws = p.ws;
    gemm_unit(xb, DM, win_t, DM, DM, brow, bcol,
      [&](int ai, int bj, int m, int n, f32x4 a, int row0, int col) {
        float v[4];
#pragma unroll
        for (int j = 0; j < 4; ++j) v[j] = a[j] * rstd[row0 + j];
        if (pn < 26) {
          const int sec = pn >> 1;
          const int br = sec >> 2, kind = (pn < 24) ? (sec & 3) : 0;
          const int c = col - sec * 512;
          const bool rope_on = (pn >= 24) || ((kind == 0 || kind == 1) && br < 2);
          if (rope_on && n == 0 && (wc & 1) == 0) {
            const int i = fr & 7; const float sg = (fr < 8) ? -1.f : 1.f;
#pragma unroll
            for (int j = 0; j < 4; ++j) {
              const float pr = __shfl_xor(v[j], 8);
              const float2 cs = rope[((row0 + j) & (SEQ - 1)) * 8 + i];
              v[j] = v[j] * cs.x + sg * pr * cs.y;
            }
          }
          if (pn >= 24) {
            u16* qi = (u16*)(ws + OFF_QI);
#pragma unroll
            for (int j = 0; j < 4; ++j) qi[(size_t)(row0 + j) * 512 + c] = f2bf(v[j]);
          } else if (kind == 0) {
            u16* q = (u16*)(ws + OFF_Q0 + (size_t)br * 32 * MiB);
#pragma unroll
            for (int j = 0; j < 4; ++j) q[(size_t)(row0 + j) * 512 + c] = f2bf(v[j] * QSCALE);
          } else if (kind == 1) {
            u16* k = (u16*)(ws + OFF_Q0 + (size_t)br * 32 * MiB + 16 * MiB);
#pragma unroll
            for (int j = 0; j < 4; ++j) k[(size_t)(row0 + j) * 512 + c] = f2bf(v[j]);
          } else if (kind == 2) {
            u16* vt = (u16*)(ws + OFF_VT0 + (size_t)br * 16 * MiB);
            const int b = row0 >> 12, s = row0 & (SEQ - 1);
            u32x2 o; o[0] = pk2(v[0], v[1]); o[1] = pk2(v[2], v[3]);
            *(u32x2*)(vt + ((size_t)(b * 8 + (c >> 6)) * 64 + (c & 63)) * SEQ + s) = o;
          } else {
            u16* gp = (u16*)(ws + OFF_G0 + (size_t)br * 16 * MiB);
#pragma unroll
            for (int j = 0; j < 4; ++j) { const float x = v[j]; gp[(size_t)(row0 + j) * 512 + c] = f2bf(x / (1.f + __expf(-x))); }
          }
        } else {
          const int c = col - 26 * 256;
          if (c < 64) {
            if (c < 16) {
              const int i = fr & 7; const float sg = (fr < 8) ? -1.f : 1.f;
#pragma unroll
              for (int j = 0; j < 4; ++j) {
                const float pr = __shfl_xor(v[j], 8);
                const float2 cs = rope[((row0 + j) & (SEQ - 1)) * 8 + i];
                v[j] = v[j] * cs.x + sg * pr * cs.y;
              }
            }
            u16* ki = (u16*)(ws + OFF_KI);
#pragma unroll
            for (int j = 0; j < 4; ++j) ki[(size_t)(row0 + j) * 64 + c] = f2bf(v[j]);
          } else if (c < 72) {
            float* wi = (float*)(ws + OFF_WI);
#pragma unroll
            for (int j = 0; j < 4; ++j) wi[(size_t)(row0 + j) * 8 + (c - 64)] = v[j] * 0.04419417382415922f;
          } else if (c < 80) {
            float* lf = (float*)(ws + OFF_LF);
            const float bias = fb[c - 72];
#pragma unroll
            for (int j = 0; j < 4; ++j) { const float z = v[j] + bias; lf[(size_t)(row0 + j) * 8 + (c - 72)] = fminf(z, 0.f) - log1pf(__expf(-fabsf(z))); }
          }
        }
      });
  }
}

DI unsigned umap(float f) { unsigned u = __float_as_uint(f); return (u & 0x80000000u) ? ~u : (u | 0x80000000u); }

DI void select_item(const Params& p, int b, int t0) {
  extern __shared__ __attribute__((aligned(16))) char smem[];
  unsigned* sc = (unsigned*)smem;
  const int tid = ltid(), wave = tid >> 6, lane = tid & 63, r = lane & 31, half = lane >> 5;
  const u16* qi = (const u16*)(p.ws + OFF_QI);
  const u16* ki = (const u16*)(p.ws + OFF_KI);
  const float* wi = (const float*)(p.ws + OFF_WI);
  const int nkt = t0 / 32 + 1;
  {
    bf16x8 aq[2][4];
    const int i_ = (r & 3) | ((r >> 3) << 2), hh = (r >> 2) & 1;
#pragma unroll
    for (int be = 0; be < 2; ++be) {
      const int qloc = 4 * be + 2 * hh + (i_ >> 3), head = i_ & 7;
      const u16* src = qi + (size_t)(b * SEQ + t0 + qloc) * 512 + head * 64 + 8 * half;
#pragma unroll
      for (int ks = 0; ks < 4; ++ks) aq[be][ks] = *(const bf16x8*)(src + 16 * ks);
    }
    float wv[2][16];
#pragma unroll
    for (int be = 0; be < 2; ++be)
#pragma unroll
      for (int e = 0; e < 2; ++e) {
        const float4* w4 = (const float4*)(wi + (size_t)(b * SEQ + t0 + 4 * be + 2 * half + e) * 8);
        const float4 a = w4[0], c = w4[1];
        wv[be][8 * e + 0] = a.x; wv[be][8 * e + 1] = a.y; wv[be][8 * e + 2] = a.z; wv[be][8 * e + 3] = a.w;
        wv[be][8 * e + 4] = c.x; wv[be][8 * e + 5] = c.y; wv[be][8 * e + 6] = c.z; wv[be][8 * e + 7] = c.w;
      }
    for (int kt = wave; kt < nkt; kt += 8) {
      const int key = 32 * kt + r;
      const u16* ksrc = ki + (size_t)(b * SEQ + key) * 64 + 8 * half;
      bf16x8 bk[4];
#pragma unroll
      for (int ks = 0; ks < 4; ++ks) bk[ks] = *(const bf16x8*)(ksrc + 16 * ks);
#pragma unroll
      for (int be = 0; be < 2; ++be) {
        f32x16 c;
#pragma unroll
        for (int i = 0; i < 16; ++i) c[i] = 0.f;
#pragma unroll
        for (int ks = 0; ks < 4; ++ks) c = __builtin_amdgcn_mfma_f32_32x32x16_bf16(aq[be][ks], bk[ks], c, 0, 0, 0);
#pragma unroll
        for (int e = 0; e < 2; ++e) {
          float s = 0.f;
#pragma unroll
          for (int i = 0; i < 8; ++i) s = fmaf(wv[be][8 * e + i], fmaxf(c[8 * e + i], 0.f), s);
          if (s == 0.f) s = 0.f;
          const int q = 4 * be + 2 * half + e;
          sc[q * 4128 + key] = (key <= t0 + q) ? umap(s) : 0u;
        }
      }
    }
  }
  __syncthreads();
  {
    const int t = t0 + wave;
    const int L = t + 1;
    const int nvalid = 32 * nkt;
    const int nreg = (nvalid + 63) >> 6;
    unsigned v[64];
#pragma unroll
    for (int j = 0; j < 64; ++j) v[j] = 0u;
    const int ngrp = (nreg + 15) >> 4;
#pragma unroll
    for (int gq = 0; gq < 4; ++gq) {
      if (gq < ngrp) {
#pragma unroll
        for (int jj = 0; jj < 16; ++jj) { const int j = gq * 16 + jj; const int key = 64 * j + lane; if (key < nvalid) v[j] = sc[wave * 4128 + key]; }
      }
    }
    unsigned thr = 1u;
    int need_eq = -1;
    if (L > 256) {
      unsigned P = 0u; bool done = false;
      for (int bit = 31; bit >= 0; --bit) {
        const unsigned cand = P | (1u << bit);
        int c = 0;
#pragma unroll
        for (int gq = 0; gq < 4; ++gq) {
          if (gq < ngrp) {
#pragma unroll
            for (int jj = 0; jj < 16; ++jj) c += __popcll(__ballot(v[gq * 16 + jj] >= cand));
          }
        }
        if (c >= 256) P = cand;
        if (c == 256) { done = true; break; }
      }
      thr = P;
      if (!done) {
        int cge = 0, cgt = 0;
#pragma unroll
        for (int j = 0; j < 64; ++j) { cge += __popcll(__ballot(v[j] >= P)); cgt += __popcll(__ballot(v[j] > P)); }
        if (cge > 256) need_eq = 256 - cgt;
      }
    }
    unsigned long long mine = 0ull;
    if (need_eq < 0) {
#pragma unroll
      for (int gq = 0; gq < 4; ++gq) {
        if (gq < ngrp) {
#pragma unroll
          for (int jj = 0; jj < 16; ++jj) { const int j = gq * 16 + jj; const unsigned long long bm = __ballot(v[j] >= thr); if (lane == j) mine = bm; }
        }
      }
    } else {
      int eq_seen = 0;
#pragma unroll
      for (int j = 0; j < 64; ++j) {
        const bool eq = v[j] == thr;
        const unsigned long long eb = __ballot(eq);
        const int rank = eq_seen + __popcll(eb & ((1ull << lane) - 1ull));
        const bool sel = (v[j] > thr) || (eq && rank < need_eq);
        eq_seen += __popcll(eb);
        const unsigned long long bm = __ballot(sel);
        if (lane == j) mine = bm;
      }
    }
    unsigned long long* mrow = (unsigned long long*)(p.ws + OFF_MASK) + (size_t)(b * SEQ + t) * 64;
    mrow[lane] = mine;
  }
  __syncthreads();
}

DI void phase_select(const Params& p) {
  const int g = blockIdx.x, G = gridDim.x;
  const int tid = ltid(), wave = tid >> 6, lane = tid & 63;
  __shared__ __attribute__((aligned(16))) float red[8][64];
  for (int it = g * 8 + wave; it < NBATCH * NH; it += G * 8) {
    const int b = it >> 3, h = it & 7;
    const float* lf = (const float*)(p.ws + OFF_LF) + (size_t)b * SEQ * 8 + h;
    float* cs = (float*)(p.ws + OFF_CS) + (size_t)it * SEQ;
    float loc[64]; float run = 0.f;
#pragma unroll
    for (int i = 0; i < 64; ++i) { run += lf[(size_t)(lane * 64 + i) * 8]; loc[i] = run; }
    float incl = run;
#pragma unroll
    for (int o = 1; o < 64; o <<= 1) { const float t = __shfl_up(incl, o); if (lane >= o) incl += t; }
    const float base = incl - run;
#pragma unroll
    for (int i = 0; i < 64; ++i) cs[lane * 64 + i] = (base + loc[i]) * LOG2E;
  }
  for (int pr = g; pr < 256; pr += G) {
    const int item = pr * 2 + (wave >> 2);
    const int b = item >> 7, h = (item >> 4) & 7, n = item & 15;
    const u16* k = (const u16*)(p.ws + OFF_Q0 + 16 * MiB) + (size_t)(b * SEQ + n * 256 + (wave & 3) * 64) * 512 + h * 64 + lane;
    float s = 0.f;
    for (int i = 0; i < 64; ++i) s += bf2f(k[(size_t)i * 512]);
    red[wave][lane] = s;
    __syncthreads();
    if ((wave & 3) == 0) {
      const float tot = red[wave][lane] + red[wave + 1][lane] + red[wave + 2][lane] + red[wave + 3][lane];
      ((float*)(p.ws + OFF_KMEAN))[(size_t)item * 64 + lane] = tot * (1.f / 256.f);
    }
    __syncthreads();
  }
  for (int j = 0; j * G < 2048; ++j) {
    const int idx = j * G + ((j & 1) ? (G - 1 - g) : g);
    if (idx < 2048) {
      const int tg = 511 - (idx >> 2), b = idx & 3;
      select_item(p, b, tg * 8);
    }
  }
}

DI int perm23(int r) { return (r & ~12) | ((r & 4) << 1) | ((r & 8) >> 1); }

DI void attn_item(const Params& p, int br, int b, int h, int qb) {
  extern __shared__ __attribute__((aligned(16))) char smem[];
  u16* Ks = (u16*)smem;
  u16* Vs = (u16*)(smem + 2 * 64 * 144);
  float* cks = (float*)(smem + 4 * 64 * 144);
  const int tid = ltid(), wave = tid >> 6, lane = tid & 63, r = lane & 31, half = lane >> 5;
  const u16* Qp = (const u16*)(p.ws + OFF_Q0 + (size_t)br * 32 * MiB);
  const u16* Kp = (const u16*)(p.ws + OFF_Q0 + (size_t)br * 32 * MiB + 16 * MiB);
  const u16* VTp = (const u16*)(p.ws + OFF_VT0 + (size_t)br * 16 * MiB) + (size_t)(b * 8 + h) * 64 * SEQ;
  u16* Gp = (u16*)(p.ws + OFF_G0 + (size_t)br * 16 * MiB);
  const float* csrow = (const float*)(p.ws + OFF_CS) + (size_t)(b * 8 + h) * SEQ;
  const unsigned* maskp = (const unsigned*)(p.ws + OFF_MASK);
  const int qpos = qb * 256 + wave * 32 + r;
  const size_t qtok = (size_t)b * SEQ + qpos;

  bf16x8 qf[4];
#pragma unroll
  for (int ks = 0; ks < 4; ++ks) qf[ks] = *(const bf16x8*)(Qp + qtok * 512 + h * 64 + 16 * ks + 8 * half);

  unsigned selmask = 0u;
  if (br == 0 && qb > 0) {
    if (qb <= 3) selmask = (1u << qb) - 1u;
    else {
      const float* km = (const float*)(p.ws + OFF_KMEAN) + (size_t)(b * 8 + h) * 16 * 64;
      float qv[64];
      const u16* qrow = Qp + qtok * 512 + h * 64;
#pragma unroll
      for (int c8 = 0; c8 < 8; ++c8) {
        const u32x4 w = *(const u32x4*)(qrow + 8 * c8);
#pragma unroll
        for (int e = 0; e < 4; ++e) { qv[8 * c8 + 2 * e] = bf2f(w[e] & 0xffffu); qv[8 * c8 + 2 * e + 1] = bf2f(w[e] >> 16); }
      }
      float v0 = -INFINITY, v1 = -INFINITY, v2 = -INFINITY; int i0 = 0, i1 = 0, i2 = 0;
      for (int n = 0; n < qb; ++n) {
        float gsc = 0.f;
#pragma unroll
        for (int d = 0; d < 64; ++d) gsc = fmaf(qv[d], km[n * 64 + d], gsc);
        if (gsc > v0) { v2 = v1; i2 = i1; v1 = v0; i1 = i0; v0 = gsc; i0 = n; }
        else if (gsc > v1) { v2 = v1; i2 = i1; v1 = gsc; i1 = n; }
        else if (gsc > v2) { v2 = gsc; i2 = n; }
      }
      selmask = (1u << i0) | (1u << i1) | (1u << i2);
    }
  }
  const float cq = (br == 2) ? csrow[qpos] : 0.f;

  const int nkt = (qb + 1) * 4;
  const int my_last = qb * 4 + (wave >> 1);
  const int lrow = tid >> 3, lchunk = tid & 7;
  const u16* ksrc = Kp + ((size_t)b * SEQ + lrow) * 512 + h * 64 + lchunk * 8;
  const u16* vsrc = VTp + (size_t)lrow * SEQ + lchunk * 8;
  u32x4 kreg = *(const u32x4*)(ksrc);
  u32x4 vreg = *(const u32x4*)(vsrc);
  float creg = 0.f;
  if (br == 2 && tid < 64) creg = csrow[tid];
  __syncthreads();
  *(u32x4*)(Ks + lrow * 72 + lchunk * 8) = kreg;
  *(u32x4*)(Vs + lrow * 72 + lchunk * 8) = vreg;
  if (br == 2 && tid < 64) cks[tid] = creg;
  __syncthreads();

  f32x16 o0, o1;
#pragma unroll
  for (int i = 0; i < 16; ++i) { o0[i] = 0.f; o1[i] = 0.f; }
  float mrun = -1e30f, lrun = 0.f;
  const int kr = perm23(r);

  for (int kt = 0; kt < nkt; ++kt) {
    const int cur = kt & 1;
    const bool more = (kt + 1 < nkt);
    if (more) {
      kreg = *(const u32x4*)(ksrc + (size_t)(kt + 1) * 64 * 512);
      vreg = *(const u32x4*)(vsrc + (kt + 1) * 64);
      if (br == 2 && tid < 64) creg = csrow[(kt + 1) * 64 + tid];
    }
    if (kt <= my_last) {
      const u16* Kb = Ks + cur * 64 * 72;
      const u16* Vb = Vs + cur * 64 * 72;
      f32x16 s0, s1;
#pragma unroll
      for (int i = 0; i < 16; ++i) { s0[i] = 0.f; s1[i] = 0.f; }
#pragma unroll
      for (int ks = 0; ks < 4; ++ks) {
        const bf16x8 k0 = *(const bf16x8*)(Kb + (kr) * 72 + 16 * ks + 8 * half);
        const bf16x8 k1 = *(const bf16x8*)(Kb + (32 + kr) * 72 + 16 * ks + 8 * half);
        s0 = __builtin_amdgcn_mfma_f32_32x32x16_bf16(k0, qf[ks], s0, 0, 0, 0);
        s1 = __builtin_amdgcn_mfma_f32_32x32x16_bf16(k1, qf[ks], s1, 0, 0, 0);
      }
      if (br == 2) {
        const float* cb = cks + cur * 64;
#pragma unroll
        for (int i = 0; i < 16; ++i) {
          const int ko = (i & 7) + 8 * half + 16 * (i >> 3);
          s0[i] += cq - cb[ko];
          s1[i] += cq - cb[32 + ko];
        }
      }
      bool lane_on = true;
      const bool diag = (kt >= qb * 4);
      if (br == 1 || diag) {
        unsigned w0, w1;
        if (br == 1) {
          const u32x2 mw = *(const u32x2*)(maskp + qtok * 128 + 2 * kt);
          w0 = mw[0]; w1 = mw[1];
        } else {
          const int nv0 = qpos - 64 * kt + 1, nv1 = nv0 - 32;
          w0 = nv0 >= 32 ? 0xffffffffu : (nv0 <= 0 ? 0u : ((1u << nv0) - 1u));
          w1 = nv1 >= 32 ? 0xffffffffu : (nv1 <= 0 ? 0u : ((1u << nv1) - 1u));
        }
        w0 >>= (8 * half); w1 >>= (8 * half);
#pragma unroll
        for (int i = 0; i < 16; ++i) {
          const int bitp = (i & 7) + 16 * (i >> 3);
          s0[i] = ((w0 >> bitp) & 1u) ? s0[i] : -INFINITY;
          s1[i] = ((w1 >> bitp) & 1u) ? s1[i] : -INFINITY;
        }
      } else if (br == 0) {
        lane_on = (selmask >> (kt >> 2)) & 1u;
      }
      float tmax = -INFINITY;
#pragma unroll
      for (int i = 0; i < 16; ++i) tmax = fmaxf(tmax, fmaxf(s0[i], s1[i]));
      tmax = fmaxf(tmax, __shfl_xor(tmax, 32));
      if (!lane_on) tmax = -INFINITY;
      const float mnew = fmaxf(mrun, tmax);
      const float alpha = fast_exp2(mrun - mnew);
      mrun = mnew;
      const float sub = lane_on ? mnew : INFINITY;
      float psum = 0.f;
#pragma unroll
      for (int i = 0; i < 16; ++i) { s0[i] = fast_exp2(s0[i] - sub); s1[i] = fast_exp2(s1[i] - sub); psum += s0[i] + s1[i]; }
      lrun = lrun * alpha + psum;
      if (__ballot(alpha != 1.f) != 0ull) {
#pragma unroll
        for (int i = 0; i < 16; ++i) { o0[i] *= alpha; o1[i] *= alpha; }
      }
      bf16x8 pf[4];
      {
        u32x4 t;
        t[0] = pk2(s0[0], s0[1]); t[1] = pk2(s0[2], s0[3]); t[2] = pk2(s0[4], s0[5]); t[3] = pk2(s0[6], s0[7]); pf[0] = __builtin_bit_cast(bf16x8, t);
        t[0] = pk2(s0[8], s0[9]); t[1] = pk2(s0[10], s0[11]); t[2] = pk2(s0[12], s0[13]); t[3] = pk2(s0[14], s0[15]); pf[1] = __builtin_bit_cast(bf16x8, t);
        t[0] = pk2(s1[0], s1[1]); t[1] = pk2(s1[2], s1[3]); t[2] = pk2(s1[4], s1[5]); t[3] = pk2(s1[6], s1[7]); pf[2] = __builtin_bit_cast(bf16x8, t);
        t[0] = pk2(s1[8], s1[9]); t[1] = pk2(s1[10], s1[11]); t[2] = pk2(s1[12], s1[13]); t[3] = pk2(s1[14], s1[15]); pf[3] = __builtin_bit_cast(bf16x8, t);
      }
#pragma unroll
      for (int kk = 0; kk < 4; ++kk) {
        const bf16x8 va = *(const bf16x8*)(Vb + (r) * 72 + 16 * kk + 8 * half);
        const bf16x8 vb = *(const bf16x8*)(Vb + (32 + r) * 72 + 16 * kk + 8 * half);
        o0 = __builtin_amdgcn_mfma_f32_32x32x16_bf16(va, pf[kk], o0, 0, 0, 0);
        o1 = __builtin_amdgcn_mfma_f32_32x32x16_bf16(vb, pf[kk], o1, 0, 0, 0);
      }
    }
    if (more) {
      const int nx = cur ^ 1;
      *(u32x4*)(Ks + nx * 64 * 72 + lrow * 72 + lchunk * 8) = kreg;
      *(u32x4*)(Vs + nx * 64 * 72 + lrow * 72 + lchunk * 8) = vreg;
      if (br == 2 && tid < 64) cks[nx * 64 + tid] = creg;
    }
    __syncthreads();
  }
  const float ltot = lrun + __shfl_xor(lrun, 32);
  const float inv = 1.f / ltot;
  u16* grow = Gp + qtok * 512 + h * 64;
#pragma unroll
  for (int db = 0; db < 2; ++db)
#pragma unroll
    for (int g4 = 0; g4 < 4; ++g4) {
      const int d0 = 32 * db + 8 * g4 + 4 * half;
      const u32x2 gw = *(const u32x2*)(grow + d0);
      float a[4];
#pragma unroll
      for (int e = 0; e < 4; ++e) a[e] = (db == 0 ? o0[4 * g4 + e] : o1[4 * g4 + e]) * inv;
      u32x2 ow;
      ow[0] = pk2(a[0] * bf2f(gw[0] & 0xffffu), a[1] * bf2f(gw[0] >> 16));
      ow[1] = pk2(a[2] * bf2f(gw[1] & 0xffffu), a[3] * bf2f(gw[1] >> 16));
      *(u32x2*)(grow + d0) = ow;
    }
}

DI void phase_attn(const Params& p) {
  const int g = blockIdx.x, G = gridDim.x;
  constexpr int NI = 3 * NBATCH * NH * 16;
  for (int j = 0; j * G < NI; ++j) {
    const int idx = j * G + ((j & 1) ? (G - 1 - g) : g);
    if (idx < NI) {
      const int qb = 15 - idx / 96, rem = idx % 96;
      const int br = rem % 3, bh = rem / 3;
      attn_item(p, br, bh >> 3, bh & 7, qb);
    }
  }
}

DI void phase_merge(const Params& p) {
  const u16* xb = (const u16*)(p.ws + OFF_XB);
  const u16* wm_t = (const u16*)(p.ws + OFF_WIN) + (size_t)N1 * DM;
  const u16* wbr_t = (const u16*)(p.ws + OFF_WBR);
  const float* rstd = (const float*)(p.ws + OFF_RSTD);
  u16* merged = (u16*)(p.ws + OFF_MERGED);
  char* scr = p.ws + OFF_SCR + (size_t)blockIdx.x * 384 * 1024;
  u32x2* sig = (u32x2*)scr;
  f32x4* part = (f32x4*)(scr + 128 * 1024);
  const int tid = ltid();
  for (int u = blockIdx.x; u < 256; u += gridDim.x) {
    const int pn = u / 64, pm = u % 64;
    const int brow = pm * 256, bcol = pn * 256;
    for (int nb = 0; nb < 3; ++nb) {
      gemm_unit(xb, DM, wm_t + (size_t)nb * DM * DM, DM, DM, brow, bcol,
        [&](int ai, int bj, int m, int n, f32x4 a, int row0, int col) {
          float v[4];
#pragma unroll
          for (int j = 0; j < 4; ++j) { const float z = a[j] * rstd[row0 + j]; v[j] = 1.f / (1.f + __expf(-z)); }
          u32x2 o; o[0] = pk2(v[0], v[1]); o[1] = pk2(v[2], v[3]);
          int t_ = tid; asm volatile("" : "+v"(t_));
          sig[(((ai * 2 + bj) * 4 + m) * 2 + n) * 512 + t_] = o;
        });
      const u16* gp = (const u16*)(p.ws + OFF_G0 + (size_t)nb * 16 * MiB);
      gemm_unit(gp, WID, wbr_t + (size_t)nb * DM * WID, WID, WID, brow, bcol,
        [&](int ai, int bj, int m, int n, f32x4 a, int row0, int col) {
          int t_ = tid; asm volatile("" : "+v"(t_));
          const int slot = (((ai * 2 + bj) * 4 + m) * 2 + n) * 512 + t_;
          const u32x2 sg = sig[slot];
          f32x4 v;
          v[0] = a[0] * bf2f(sg[0] & 0xffffu); v[1] = a[1] * bf2f(sg[0] >> 16);
          v[2] = a[2] * bf2f(sg[1] & 0xffffu); v[3] = a[3] * bf2f(sg[1] >> 16);
          if (nb > 0) { const f32x4 pv = part[slot]; v += pv; }
          if (nb < 2) part[slot] = v;
          else {
#pragma unroll
            for (int j = 0; j < 4; ++j) merged[(size_t)(row0 + j) * DM + col] = f2bf(v[j]);
          }
        });
    }
  }
}

DI void phase_out(const Params& p, int layer) {
  const u16* merged = (const u16*)(p.ws + OFF_MERGED);
  const u16* wout_t = (const u16*)(p.ws + OFF_WOUT);
  const float* resid = layer == 0 ? p.x : p.out;
  float* out = p.out;
  for (int u = blockIdx.x; u < 256; u += gridDim.x) {
    const int pn = u / 64, pm = u % 64;
    gemm_unit(merged, DM, wout_t, DM, DM, pm * 256, pn * 256,
      [&](int ai, int bj, int m, int n, f32x4 a, int row0, int col) {
#pragma unroll
        for (int j = 0; j < 4; ++j) { const size_t o = (size_t)(row0 + j) * DM + col; out[o] = resid[o] + a[j]; }
      });
  }
}

DI void phase_final(const Params& p) {
  const int tid_ = ltid(), wave = tid_ >> 6, lane = tid_ & 63;
  const float4* g4 = (const float4*)p.final_gain;
  for (int row = blockIdx.x * 8 + wave; row < T_TOK; row += gridDim.x * 8) {
    float4* s4 = (float4*)(p.out + (size_t)row * DM);
    float4 v[4]; float ss = 0.f;
#pragma unroll
    for (int i = 0; i < 4; ++i) { v[i] = s4[lane + 64 * i]; ss += v[i].x * v[i].x + v[i].y * v[i].y + v[i].z * v[i].z + v[i].w * v[i].w; }
    ss = wave_sum(ss);
    const float rs = rsqrtf(ss * (1.0f / DM) + 1e-6f);
#pragma unroll
    for (int i = 0; i < 4; ++i) {
      const float4 gg = g4[lane + 64 * i];
      float4 o; o.x = v[i].x * rs * gg.x; o.y = v[i].y * rs * gg.y; o.z = v[i].z * rs * gg.z; o.w = v[i].w * rs * gg.w;
      s4[lane + 64 * i] = o;
    }
  }
}


#define XB_TMO      128
#define XB_XCNT(j)  (256  + 64 * (j))
#define XB_XSUB(j)  (1280 + 64 * (j))
#define XB_XGEN(j)  (2304 + 64 * (j))
#define XB_TOP      3328
#define XB_TOPGEN   3392
#define XCD_BAR_WORDS 3456
#define XB_SPIN_CAP (1u << 22)
#define LAS __attribute__((address_space(3)))
DI unsigned xb_ld(unsigned* p)              { return __hip_atomic_load(p, __ATOMIC_RELAXED, __HIP_MEMORY_SCOPE_AGENT); }
DI unsigned xb_add(unsigned* p, unsigned v) { return __hip_atomic_fetch_add(p, v, __ATOMIC_RELAXED, __HIP_MEMORY_SCOPE_AGENT); }
DI unsigned xb_xcc_id() { return (unsigned)__builtin_amdgcn_s_getreg((3 << 11) | 20) & 0xFu; }
#define XB_SPIN(cond, bar) do { unsigned _sp = 0; while (cond) { __builtin_amdgcn_s_sleep(1); \
    if ((++_sp & 255u) == 0u) { if (xb_ld(&(bar)[XB_TMO])) break; if (_sp > XB_SPIN_CAP) { atomicAdd(&(bar)[XB_TMO], 1u); break; } } } } while (0)
struct XcdBarrier { unsigned* bar; unsigned x; volatile LAS unsigned* st; };
DI XcdBarrier xcd_barrier_post(unsigned* bar, volatile LAS unsigned* st) {
  XcdBarrier b; b.bar = bar; b.x = xb_xcc_id(); b.st = st;
  if (threadIdx.x == 0) (void)xb_add(&bar[XB_XCNT(b.x)], 1u);
  return b;
}
DI void xcd_barrier_complete(unsigned* bar, unsigned x, unsigned& nloc, unsigned& nx) {
  const unsigned G = gridDim.x * gridDim.y * gridDim.z;
  unsigned sum, cnt, mine, sp = 0u;
  for (;;) {
    sum = 0u; cnt = 0u; mine = 0u;
#pragma unroll
    for (unsigned j = 0; j < 16; ++j) { const unsigned c = xb_ld(&bar[XB_XCNT(j)]); sum += c; cnt += (c > 0u) ? 1u : 0u; mine = (j == x) ? c : mine; }
    if (sum == G) break;
    __builtin_amdgcn_s_sleep(1);
    if ((++sp & 255u) == 0u) { if (xb_ld(&bar[XB_TMO])) break; if (sp > XB_SPIN_CAP) { atomicAdd(&bar[XB_TMO], 1u); break; } }
  }
  nloc = mine > 0u ? mine : 1u; nx = cnt > 0u ? cnt : 1u;
}
DI void xcd_barrier(const XcdBarrier& b) {
  asm volatile("s_waitcnt vmcnt(0)" ::: "memory");
  __syncthreads();
  if (threadIdx.x == 0) {
    unsigned* bar = b.bar;
    __builtin_amdgcn_s_waitcnt(0);
    unsigned nloc = b.st[0], nx = b.st[1];
    if (nloc == 0u) { xcd_barrier_complete(bar, b.x, nloc, nx); b.st[0] = nloc; b.st[1] = nx; }
    const unsigned old = xb_add(&bar[XB_XSUB(b.x)], 1u);
    const unsigned gen = old / nloc;
    if (old + 1u == (gen + 1u) * nloc) {
      __builtin_amdgcn_fence(__ATOMIC_RELEASE, "agent");
      asm volatile("s_waitcnt vmcnt(0)" ::: "memory");
      const unsigned og = xb_add(&bar[XB_TOP], 1u);
      const unsigned tg = og / nx;
      if (og + 1u == (tg + 1u) * nx) xb_add(&bar[XB_TOPGEN], 1u);
      else XB_SPIN(xb_ld(&bar[XB_TOPGEN]) == tg, bar);
      __builtin_amdgcn_fence(__ATOMIC_ACQUIRE, "agent");
      xb_add(&bar[XB_XGEN(b.x)], 1u);
      asm volatile("s_waitcnt vmcnt(0)" ::: "memory");
    } else {
      XB_SPIN(xb_ld(&bar[XB_XGEN(b.x)]) == gen, bar);
      __builtin_amdgcn_fence(__ATOMIC_ACQUIRE, "agent");
      asm volatile("s_waitcnt vmcnt(0)" ::: "memory");
    }
  }
  __syncthreads();
}

__global__ void __launch_bounds__(NTHR) mega(Params p, int ph_lo, int ph_hi) {
  cg::grid_group grid = cg::this_grid();
  __shared__ uint4 xb_words;
  if (threadIdx.x == 0) xb_words = make_uint4(0u, 0u, 0u, 0u);
  __syncthreads();
  XcdBarrier xb = xcd_barrier_post((unsigned*)(p.ws + OFF_BAR), (volatile LAS unsigned*)&xb_words);
  for (int ph = ph_lo; ph < ph_hi; ++ph) {
    if (ph == 12) phase_final(p);
    else {
      const int layer = ph / 6, k = ph % 6;
      if (k == 0) phase_prep(p, layer);
      else if (k == 1) phase_proj(p, layer);
      else if (k == 2) phase_select(p);
      else if (k == 3) phase_attn(p);
      else if (k == 4) phase_merge(p);
      else phase_out(p, layer);
    }
    if (ph + 1 < ph_hi) {
      if (ph == ph_lo) grid.sync();
      else xcd_barrier(xb);
    }
  }
}

extern "C" void kernel_launch(void* const* d_in, const int* in_sizes, int n_in, void* d_out, int out_size,
                              void* d_ws, size_t ws_size, hipStream_t stream) {
  if (ws_size < WS_NEED) { fprintf(stderr, "workspace too small: %zu < %zu\n", ws_size, (size_t)WS_NEED); return; }
  Params p{};
  p.x = (const float*)d_in[0]; p.norm_gain = (const float*)d_in[1]; p.w_in = (const float*)d_in[2];
  p.fbias = (const float*)d_in[3]; p.w_branch = (const float*)d_in[4]; p.w_out = (const float*)d_in[5];
  p.final_gain = (const float*)d_in[6];
  p.out = (float*)d_out; p.ws = (char*)d_ws;
  (void)hipFuncSetAttribute((const void*)mega, hipFuncAttributeMaxDynamicSharedMemorySize, SMEM_BYTES);
  static int grid = 0;
  if (!grid) {
    int dev = 0, cus = 0, per_cu = 0;
    hipGetDevice(&dev);
    hipDeviceGetAttribute(&cus, hipDeviceAttributeMultiprocessorCount, dev);
    hipOccupancyMaxActiveBlocksPerMultiprocessor(&per_cu, (const void*)mega, NTHR, SMEM_BYTES);
    if (per_cu < 1) per_cu = 1;
    grid = cus;
    if (grid > 256) grid = 256;
  }
  (void)hipMemsetAsync((char*)d_ws + OFF_BAR, 0, 16384, stream);
  int lo = 0, hi = 13;
  void* args[] = {&p, &lo, &hi};
  hipError_t e = hipLaunchCooperativeKernel((const void*)mega, dim3(grid), dim3(NTHR), args, SMEM_BYTES, stream);
  if (e != hipSuccess) fprintf(stderr, "cooperative launch failed: %s (grid %d)\n", hipGetErrorString(e), grid);
}
```

```cpp
#include <hip/hip_runtime.h>
#include <hip/hip_bf16.h>
#include <hip/hip_cooperative_groups.h>
#include <cstdio>
#include <cstdint>
namespace cg = cooperative_groups;

typedef unsigned short u16;
using bf16x8 = __attribute__((ext_vector_type(8))) short;
using f32x4  = __attribute__((ext_vector_type(4))) float;
using f32x16 = __attribute__((ext_vector_type(16))) float;
using u32x2  = __attribute__((ext_vector_type(2))) unsigned;
using u32x4  = __attribute__((ext_vector_type(4))) unsigned;
#define DI __device__ __forceinline__

constexpr int T_TOK = 16384, SEQ = 4096, NBATCH = 4, DM = 1024, NH = 8, HD = 64, WID = 512;
constexpr int D_IN = 9808;
constexpr int N1 = 6912;
constexpr int N1_VALID = 6736;
constexpr int NMERGE = 3072;
constexpr int NWROWS = N1 + NMERGE;
constexpr float QSCALE = 0.125f * 1.4426950408889634f;
constexpr float LOG2E = 1.4426950408889634f;
constexpr int NTHR = 512;
constexpr int PROBE_K = -1;
constexpr int SMEM_BYTES = 256 * 528;
constexpr int EPI_LD = 264;

constexpr size_t MiB = 1024 * 1024;
constexpr size_t OFF_BAR = 0;
constexpr size_t OFF_ROPE = 16384;
constexpr size_t OFF_RSTD = OFF_ROPE + 262144;
constexpr size_t OFF_WI = OFF_RSTD + 65536;
constexpr size_t OFF_LF = OFF_WI + 524288;
constexpr size_t OFF_CS = OFF_LF + 524288;
constexpr size_t OFF_KMEAN = OFF_CS + 524288;
constexpr size_t OFF_NORM = OFF_KMEAN + 131072;
constexpr size_t OFF_XB = 2 * MiB;
constexpr size_t OFF_WIN = 34 * MiB;
constexpr size_t OFF_WBR = 54 * MiB;
constexpr size_t OFF_WOUT = 57 * MiB;
constexpr size_t OFF_MASK = 59 * MiB;
constexpr size_t OFF_KI = 67 * MiB;
constexpr size_t OFF_QI = 69 * MiB;
constexpr size_t OFF_Q0 = 85 * MiB;
constexpr size_t OFF_VT0 = 181 * MiB;
constexpr size_t OFF_G0 = 229 * MiB;
constexpr size_t WS_NEED = 277 * MiB;
constexpr size_t OFF_MERGED = OFF_Q0;
constexpr size_t OFF_SCR = 117 * MiB;

struct Params {
  const float* x; const float* norm_gain; const float* w_in; const float* fbias;
  const float* w_branch; const float* w_out; const float* final_gain;
  float* out; char* ws;
};

DI unsigned pk2(float a, float b) {
  typedef __bf16 bf2 __attribute__((ext_vector_type(2)));
  typedef float f2 __attribute__((ext_vector_type(2)));
  f2 v = {a, b};
  bf2 r = __builtin_convertvector(v, bf2);
  return __builtin_bit_cast(unsigned, r);
}
DI u16 f2bf(float a) { return (u16)(pk2(a, 0.f) & 0xffffu); }
DI float bf2f(unsigned v) { return __uint_as_float(v << 16); }
DI float wave_sum(float v) {
#pragma unroll
  for (int o = 32; o > 0; o >>= 1) v += __shfl_xor(v, o);
  return v;
}
DI int wave_sum_i(int v) {
#pragma unroll
  for (int o = 32; o > 0; o >>= 1) v += __shfl_xor(v, o);
  return v;
}
DI int wave_sum_dpp(int v) {
  v += __builtin_amdgcn_mov_dpp(v, 0xB1, 0xF, 0xF, true);
  v += __builtin_amdgcn_mov_dpp(v, 0x4E, 0xF, 0xF, true);
  v += __builtin_amdgcn_mov_dpp(v, 0x141, 0xF, 0xF, true);
  v += __builtin_amdgcn_mov_dpp(v, 0x140, 0xF, 0xF, true);
  return __builtin_amdgcn_readlane(v, 0) + __builtin_amdgcn_readlane(v, 16) + __builtin_amdgcn_readlane(v, 32) + __builtin_amdgcn_readlane(v, 48);
}
DI int ltid() { int t = threadIdx.x; asm volatile("" : "+v"(t)); return t; }
DI float fast_exp2(float x) { return __builtin_amdgcn_exp2f(x); }

struct TrDesc { const float* src; int src_ld; int k0; int n0; int mode; u16* dst; int dst_ld; const float* gain; };
DI void tr_load(const TrDesc& d, int tid, float (&v)[8]) {
  const int tx = tid & 63, ty = tid >> 6;
  const int n = d.n0 + tx;
  int c = n;
  if (d.mode == 1) c = (n < N1_VALID) ? n : (n >= N1 ? n - (N1 - N1_VALID) : -1);
#pragma unroll
  for (int i = 0; i < 8; ++i) {
    const int k = d.k0 + ty + 8 * i;
    float x = 0.f;
    if (c >= 0) x = d.src[(size_t)k * d.src_ld + c];
    if (d.gain) x *= d.gain[k];
    v[i] = x;
  }
}
DI void tr_store(const TrDesc& d, int tid, const float (&v)[8], float* lds) {
  {
    const int tx = tid & 63, ty = tid >> 6;
#pragma unroll
    for (int i = 0; i < 8; ++i) lds[(ty + 8 * i) * 65 + tx] = v[i];
  }
  __syncthreads();
  {
    const int kx = (tid & 31) * 2, ny = tid >> 5;
#pragma unroll
    for (int i = 0; i < 4; ++i) {
      const int nn = ny + 16 * i;
      const unsigned pv = pk2(lds[kx * 65 + nn], lds[(kx + 1) * 65 + nn]);
      *(unsigned*)(d.dst + (size_t)(d.n0 + nn) * d.dst_ld + d.k0 + kx) = pv;
    }
  }
  __syncthreads();
}

DI void phase_prep(const Params& p, int layer) {
  extern __shared__ __attribute__((aligned(16))) char smem[];
  float* lds = (float*)smem;
  const int tid = ltid(), wave = tid >> 6, lane = tid & 63;
  const int G = gridDim.x, g = blockIdx.x;
  if (layer == 0) {
    float2* rope = (float2*)(p.ws + OFF_ROPE);
    for (int e = g * NTHR + tid; e < SEQ * 8; e += G * NTHR) {
      const int pos = e >> 3, i = e & 7;
      const float invf = i == 0 ? 1.0f : i == 1 ? 0.1939227432012558f : i == 2 ? 0.03760603070259094f : i == 3 ? 0.007292664609849453f
                       : i == 4 ? 0.0014142135623842478f : i == 5 ? 0.00027424818836152554f : i == 6 ? 5.3182957344688475e-05f : 1.0313385246263351e-05f;
      const float ang = (float)pos * invf;
      const float kf = rintf(ang * 0.6366197723675814f);
      const int kq = (int)kf;
      float rr = fmaf(kf, -1.5703125f, ang);
      rr = fmaf(kf, -4.837512969970703125e-4f, rr);
      rr = fmaf(kf, -7.54978995489188216e-8f, rr);
      const float r2 = rr * rr;
      float ks3 = -1.9515295891e-4f, kc3 = 2.443315711809948e-5f;
      asm volatile("" : "+v"(ks3), "+v"(kc3));
      const float sp = fmaf(rr * r2, fmaf(r2, fmaf(r2, ks3, 8.3321608736e-3f), -1.6666654611e-1f), rr);
      const float cp = fmaf(r2 * r2, fmaf(r2, fmaf(r2, kc3, -1.388731625493765e-3f), 4.166664568298827e-2f), fmaf(r2, -0.5f, 1.0f));
      float sn, cs;
      if ((kq & 3) == 0) { sn = sp; cs = cp; } else if ((kq & 3) == 1) { sn = cp; cs = -sp; } else if ((kq & 3) == 2) { sn = -sp; cs = -cp; } else { sn = -cp; cs = sp; }
      rope[e] = make_float2(cs, sn);
    }
  }
  {
    const float* src = layer == 0 ? p.x : p.out;
    u16* xb = (u16*)(p.ws + OFF_XB);
    float* rstd = (float*)(p.ws + OFF_RSTD);
    for (int row = g * 8 + wave; row < T_TOK; row += G * 8) {
      const float4* s4 = (const float4*)(src + (size_t)row * DM);
      float ss = 0.f;
      float4 v[4];
#pragma unroll
      for (int i = 0; i < 4; ++i) { v[i] = s4[lane + 64 * i]; ss += v[i].x * v[i].x + v[i].y * v[i].y + v[i].z * v[i].z + v[i].w * v[i].w; }
      ss = wave_sum(ss);
#pragma unroll
      for (int i = 0; i < 4; ++i) {
        u32x2 o; o[0] = pk2(v[i].x, v[i].y); o[1] = pk2(v[i].z, v[i].w);
        *(u32x2*)(xb + (size_t)row * DM + (lane + 64 * i) * 4) = o;
      }
      if (lane == 0) rstd[row] = rsqrtf(ss * (1.0f / DM) + 1e-6f);
    }
  }
  {
    const float* w_in = p.w_in + (size_t)layer * DM * D_IN;
    const float* gain = p.norm_gain + (size_t)layer * DM;
    const float* w_br = p.w_branch + (size_t)layer * 3 * WID * DM;
    const float* w_out = p.w_out + (size_t)layer * DM * DM;
    u16* win_t = (u16*)(p.ws + OFF_WIN);
    u16* wbr_t = (u16*)(p.ws + OFF_WBR);
    u16* wout_t = (u16*)(p.ws + OFF_WOUT);
    constexpr int NT_IN = 16 * (NWROWS / 64);
    constexpr int NT_BR = 3 * 8 * 16;
    constexpr int NT_OUT = 16 * 16;
    constexpr int NT_ALL = NT_IN + NT_BR + NT_OUT;
    auto desc = [&](int t) {
      TrDesc d;
      if (t < NT_IN) {
        const int kt = t & 15, nt = t >> 4;
        d.src = w_in; d.src_ld = D_IN; d.k0 = kt * 64; d.n0 = nt * 64; d.mode = 1; d.dst = win_t; d.dst_ld = DM; d.gain = gain;
      } else if (t < NT_IN + NT_BR) {
        const int u = t - NT_IN; const int nb = u / 128, r = u % 128; const int kt = r & 7, nt = r >> 3;
        d.src = w_br + (size_t)nb * WID * DM; d.src_ld = DM; d.k0 = kt * 64; d.n0 = nt * 64; d.mode = 0; d.dst = wbr_t + (size_t)nb * DM * WID; d.dst_ld = WID; d.gain = nullptr;
      } else {
        const int u = t - NT_IN - NT_BR; const int kt = u & 15, nt = u >> 4;
        d.src = w_out; d.src_ld = DM; d.k0 = kt * 64; d.n0 = nt * 64; d.mode = 0; d.dst = wout_t; d.dst_ld = DM; d.gain = nullptr;
      }
      return d;
    };
    float va[8], vb[8];
    int t = g;
    if (t < NT_ALL) { const TrDesc d0 = desc(t); tr_load(d0, tid, va); }
    for (; t < NT_ALL; t += 2 * G) {
      const TrDesc dc = desc(t);
      const bool h1 = (t + G < NT_ALL), h2 = (t + 2 * G < NT_ALL);
      if (h1) { const TrDesc dn = desc(t + G); tr_load(dn, tid, vb); }
      tr_store(dc, tid, va, lds);
      if (h1) {
        if (h2) { const TrDesc dn2 = desc(t + 2 * G); tr_load(dn2, tid, va); }
        const TrDesc dn = desc(t + G);
        tr_store(dn, tid, vb, lds);
      }
    }
  }
}

constexpr int G_BK = 64, G_HALF = 128, G_HT = G_HALF * G_BK;
DI int lds_byte(int r, int c) {
  int st = (r >> 4) * 2 + (c >> 5), rr = r & 15, cc = c & 31, ob = rr * 64 + cc * 2;
  return st * 1024 + (ob ^ (((ob >> 9) & 1) << 5));
}
DI void stage_rc(int b, int& R, int& C) {
  int st = b / 1024, sb = b % 1024, swz = sb ^ (((sb >> 9) & 1) << 5);
  R = (st >> 1) * 16 + swz / 64; C = (st & 1) * 32 + (swz % 64) / 2;
}

template <class Pre, class Epi>
DI void gemm_unit(const u16* __restrict__ A, int lda, const u16* __restrict__ Bt, int ldb, int K, int brow, int bcol, Pre&& pre, Epi&& epi) {
  extern __shared__ __attribute__((aligned(16))) char smem[];
  u16* shm = (u16*)smem;
#define SA(b, h) (shm + ((b) * 2 + (h)) * G_HT)
#define SB(b, h) (shm + (4 + (b) * 2 + (h)) * G_HT)
#define STAGE_(P, BASE, LD, br, kt, _o0, _o1) do { const char* _gp = (const char*)((BASE) + ((size_t)(br) * (LD) + (size_t)(kt) * G_BK)); \
    __builtin_amdgcn_global_load_lds((const unsigned*)(_gp + (size_t)(_o0)), \
        (__attribute__((address_space(3))) unsigned*)((char*)(P) + tidl * 16), 16, 0, 0); \
    __builtin_amdgcn_global_load_lds((const unsigned*)(_gp + (size_t)(_o1)), \
        (__attribute__((address_space(3))) unsigned*)((char*)(P) + tidl * 16 + 8192), 16, 0, 0); } while (0)
#define STAGE(P, BASE, LD, br, kt) STAGE_SEL_##BASE(P, LD, br, kt)
#define STAGE_SEL_A(P, LD, br, kt) STAGE_(P, A, LD, br, kt, offA0, offA1)
#define STAGE_SEL_Bt(P, LD, br, kt) STAGE_(P, Bt, LD, br, kt, offB0, offB1)
#define LDA(dst, b, h) for (int m = 0; m < 4; ++m) for (int k = 0; k < 2; ++k) \
    dst[m][k] = *reinterpret_cast<const bf16x8*>((char*)SA(b, h) + lds_byte(wr * 64 + m * 16 + fr, k * 32 + fq * 8))
#define LDB(dst, b, h) for (int n = 0; n < 2; ++n) for (int k = 0; k < 2; ++k) \
    dst[n][k] = *reinterpret_cast<const bf16x8*>((char*)SB(b, h) + lds_byte(wc * 32 + n * 16 + fr, k * 32 + fq * 8))
#define MMA(ai, bj, At, Bt_) do { __builtin_amdgcn_s_setprio(1); \
    for (int m = 0; m < 4; ++m) for (int n = 0; n < 2; ++n) for (int k = 0; k < 2; ++k) \
      acc[ai][bj][m][n] = __builtin_amdgcn_mfma_f32_16x16x32_bf16(At[m][k], Bt_[n][k], acc[ai][bj][m][n], 0, 0, 0); \
    __builtin_amdgcn_s_setprio(0); } while (0)
#define WAIT_V(n) asm volatile("s_waitcnt vmcnt(" #n ")" ::: "memory")
#define WAIT_L(n) asm volatile("s_waitcnt lgkmcnt(" #n ")" ::: "memory")
#define BAR __builtin_amdgcn_s_barrier()
#define SCHED __builtin_amdgcn_sched_barrier(0)
  int tidl = threadIdx.x; asm volatile("" : "+v"(tidl));
  const int wid = __builtin_amdgcn_readfirstlane(tidl >> 6), lane = tidl & 63, wr = wid >> 2, wc = wid & 3, fr = lane & 15, fq = lane >> 4;
  f32x4 acc[2][2][4][2] = {};
  bf16x8 At[4][2], B0[2][2], B1[2][2];
  const int nt = K / G_BK;
  unsigned offA0, offA1, offB0, offB1;
  { int _r, _c; stage_rc(tidl * 16, _r, _c); offA0 = (unsigned)(_r * lda + _c) * 2u; offB0 = (unsigned)(_r * ldb + _c) * 2u;
    stage_rc(tidl * 16 + 8192, _r, _c); offA1 = (unsigned)(_r * lda + _c) * 2u; offB1 = (unsigned)(_r * ldb + _c) * 2u; }
  STAGE(SB(0, 0), Bt, ldb, bcol, 0); STAGE(SA(0, 0), A, lda, brow, 0);
  STAGE(SB(0, 1), Bt, ldb, bcol + G_HALF, 0); STAGE(SA(0, 1), A, lda, brow + G_HALF, 0);
  if (wr == 1) BAR;
  WAIT_V(4); BAR;
  STAGE(SB(1, 0), Bt, ldb, bcol, 1); STAGE(SA(1, 0), A, lda, brow, 1); STAGE(SB(1, 1), Bt, ldb, bcol + G_HALF, 1);
  WAIT_V(6); BAR;
  for (int t = 0; t < nt - 2; t += 2) {
    LDB(B0, 0, 0); SCHED; LDA(At, 0, 0); STAGE(SA(1, 1), A, lda, brow + G_HALF, t + 1);
    WAIT_L(8); BAR; WAIT_L(0); MMA(0, 0, At, B0); BAR; SCHED;
    LDB(B1, 0, 1); STAGE(SB(0, 0), Bt, ldb, bcol, t + 2);
    BAR; WAIT_L(0); MMA(0, 1, At, B1); BAR;
    LDA(At, 0, 1); STAGE(SA(0, 0), A, lda, brow, t + 2);
    BAR; WAIT_L(0); MMA(1, 0, At, B0); BAR; SCHED;
    STAGE(SB(0, 1), Bt, ldb, bcol + G_HALF, t + 2);
    WAIT_V(6); BAR; MMA(1, 1, At, B1); BAR;
    LDB(B0, 1, 0); SCHED; LDA(At, 1, 0); STAGE(SA(0, 1), A, lda, brow + G_HALF, t + 2);
    WAIT_L(8); BAR; WAIT_L(0); MMA(0, 0, At, B0); BAR; SCHED;
    LDB(B1, 1, 1); STAGE(SB(1, 0), Bt, ldb, bcol, t + 3);
    BAR; WAIT_L(0); MMA(0, 1, At, B1); BAR;
    LDA(At, 1, 1); STAGE(SA(1, 0), A, lda, brow, t + 3);
    BAR; WAIT_L(0); MMA(1, 0, At, B0); BAR; SCHED;
    STAGE(SB(1, 1), Bt, ldb, bcol + G_HALF, t + 3);
    WAIT_V(6); BAR; MMA(1, 1, At, B1); BAR;
  }
  { LDB(B0, 0, 0); LDA(At, 0, 0); STAGE(SA(1, 1), A, lda, brow + G_HALF, nt - 1);
    BAR; WAIT_L(0); MMA(0, 0, At, B0); BAR;
    LDB(B1, 0, 1); BAR; WAIT_L(0); MMA(0, 1, At, B1); BAR;
    LDA(At, 0, 1); WAIT_V(4); BAR; WAIT_L(0); MMA(1, 0, At, B0); MMA(1, 1, At, B1); BAR; }
  { LDB(B0, 1, 0); LDA(At, 1, 0); WAIT_V(2); BAR; WAIT_L(0); MMA(0, 0, At, B0); BAR;
    LDB(B1, 1, 1); WAIT_V(0); BAR; WAIT_L(0); MMA(0, 1, At, B1); BAR;
    LDA(At, 1, 1); BAR; WAIT_L(0); MMA(1, 0, At, B0); MMA(1, 1, At, B1); BAR; }
  if (wr == 0) BAR;
#define PRE(ai, m) pre(ai, m, brow + ai * 128 + wr * 64 + m * 16 + fq * 4, bcol + wc * 32 + fr)
#define EPI1(ai, bj, m, n) { int _r0 = brow + ai * 128 + wr * 64 + m * 16 + fq * 4, _c0 = bcol + bj * 128 + wc * 32 + n * 16 + fr; asm volatile("" : "+v"(_r0), "+v"(_c0)); epi(ai, bj, m, n, acc[ai][bj][m][n], _r0, _c0, pcur); }
#define EPIG(ai, m, ain, mn) { auto pnext = PRE(ain, mn); EPI1(ai, 0, m, 0) EPI1(ai, 0, m, 1) EPI1(ai, 1, m, 0) EPI1(ai, 1, m, 1) pcur = pnext; SCHED; }
  auto pcur = PRE(0, 0);
  EPIG(0, 0, 0, 1) EPIG(0, 1, 0, 2) EPIG(0, 2, 0, 3) EPIG(0, 3, 1, 0) EPIG(1, 0, 1, 1) EPIG(1, 1, 1, 2) EPIG(1, 2, 1, 3) EPIG(1, 3, 1, 3)
#undef PRE
#undef EPI1
#undef EPIG
#undef SA
#undef SB
#undef STAGE
#undef STAGE_
#undef STAGE_SEL_A
#undef STAGE_SEL_Bt
#undef LDA
#undef LDB
#undef MMA
}

DI void tile_copy_out(u16* __restrict__ dst, size_t ld) {
  extern __shared__ __attribute__((aligned(16))) char smem[];
  const u16* lds16 = (const u16*)smem;
  const int tid = ltid();
  __syncthreads();
#pragma unroll 4
  for (int it = 0; it < 16; ++it) {
    const int id = it * NTHR + tid; const int row = id >> 5, cc = id & 31;
    const u32x4 v = *(const u32x4*)(lds16 + row * EPI_LD + cc * 8);
    *(u32x4*)(dst + (size_t)row * ld + cc * 8) = v;
  }
  __syncthreads();
}

DI void phase_proj(const Params& p, int layer) {
  const u16* xb = (const u16*)(p.ws + OFF_XB);
  const u16* win_t = (const u16*)(p.ws + OFF_WIN);
  const float* rstd = (const float*)(p.ws + OFF_RSTD);
  const float2* rope = (const float2*)(p.ws + OFF_ROPE);
  const float* fb = p.fbias + layer * 8;
  extern __shared__ __attribute__((aligned(16))) char smem[];
  u16* lds16 = (u16*)smem;
  const int tid_ = ltid(), lane = tid_ & 63, wid = tid_ >> 6, wc = wid & 3, fr = lane & 15;
  constexpr int NU = 64 * 27;
  for (int u = blockIdx.x; u < NU; u += gridDim.x) {
    const int pn = u / 64, pm = u % 64;
    const int brow = pm * 256, bcol = pn * 256;
    char* ws = p.ws;
    struct PreP { float rs[4]; float2 cs[4]; };
    const bool tile_rope = (pn >= 24 && pn < 27) || (pn < 24 && ((pn >> 1) & 3) < 2 && (pn >> 3) < 2);
    gemm_unit(xb, DM, win_t, DM, DM, brow, bcol,
      [&](int ai, int m, int row0, int col0) {
        PreP q;
        asm volatile("" : "+v"(row0));
#pragma unroll
        for (int j = 0; j < 4; ++j) q.rs[j] = rstd[row0 + j];
        if (tile_rope) {
#pragma unroll
          for (int j = 0; j < 4; ++j) q.cs[j] = rope[((row0 + j) & (SEQ - 1)) * 8 + (fr & 7)];
        } else {
#pragma unroll
          for (int j = 0; j < 4; ++j) q.cs[j] = make_float2(1.f, 0.f);
        }
        return q;
      },
      [&](int ai, int bj, int m, int n, f32x4 a, int row0, int col, const PreP& q) {
        float v[4];
#pragma unroll
        for (int j = 0; j < 4; ++j) v[j] = a[j] * q.rs[j];
        if (pn < 26) {
          const int sec = pn >> 1;
          const int br = sec >> 2, kind = (pn < 24) ? (sec & 3) : 0;
          const int c = col - sec * 512;
          const bool rope_on = (pn >= 24) || ((kind == 0 || kind == 1) && br < 2);
          if (rope_on && n == 0 && (wc & 1) == 0) {
            const float sg = (fr < 8) ? -1.f : 1.f;
#pragma unroll
            for (int j = 0; j < 4; ++j) {
              const float pr = __shfl_xor(v[j], 8);
              v[j] = v[j] * q.cs[j].x + sg * pr * q.cs[j].y;
            }
          }
          const int lr = row0 - brow, lc = col - bcol;
          if (pn < 24 && kind == 2) {
            u32x2 o; o[0] = pk2(v[0], v[1]); o[1] = pk2(v[2], v[3]);
            *(u32x2*)(lds16 + lc * EPI_LD + lr) = o;
          } else {
            if (pn < 24 && kind == 0) {
#pragma unroll
              for (int j = 0; j < 4; ++j) v[j] *= QSCALE;
            } else if (pn < 24 && kind == 3) {
#pragma unroll
              for (int j = 0; j < 4; ++j) v[j] = v[j] * __builtin_amdgcn_rcpf(1.f + __expf(-v[j]));
            }
#pragma unroll
            for (int j = 0; j < 4; ++j) lds16[(lr + j) * EPI_LD + lc] = f2bf(v[j]);
          }
        } else {
          const int c = col - 26 * 256;
          if (c < 64) {
            if (c < 16) {
              const float sg = (fr < 8) ? -1.f : 1.f;
#pragma unroll
              for (int j = 0; j < 4; ++j) {
                const float pr = __shfl_xor(v[j], 8);
                v[j] = v[j] * q.cs[j].x + sg * pr * q.cs[j].y;
              }
            }
            u16* ki = (u16*)(ws + OFF_KI);
#pragma unroll
            for (int j = 0; j < 4; ++j) ki[(size_t)(row0 + j) * 64 + c] = f2bf(v[j]);
          } else if (c < 72) {
            float* wi = (float*)(ws + OFF_WI);
#pragma unroll
            for (int j = 0; j < 4; ++j) wi[(size_t)(row0 + j) * 8 + (c - 64)] = v[j] * 0.04419417382415922f;
          } else if (c < 80) {
            float* lf = (float*)(ws + OFF_LF);
            const float bias = fb[c - 72];
#pragma unroll
            for (int j = 0; j < 4; ++j) { const float z = v[j] + bias; lf[(size_t)(row0 + j) * 8 + (c - 72)] = fminf(z, 0.f) - log1pf(__expf(-fabsf(z))); }
          }
        }
      });
    if (pn < 26) {
      const int sec = pn >> 1, br = sec >> 2, kind = (pn < 24) ? (sec & 3) : 0, cb = (pn & 1) * 256;
      if (pn >= 24) tile_copy_out((u16*)(ws + OFF_QI) + (size_t)brow * 512 + cb, 512);
      else if (kind == 0) tile_copy_out((u16*)(ws + OFF_Q0 + (size_t)br * 32 * MiB) + (size_t)brow * 512 + cb, 512);
      else if (kind == 1) tile_copy_out((u16*)(ws + OFF_Q0 + (size_t)br * 32 * MiB + 16 * MiB) + (size_t)brow * 512 + cb, 512);
      else if (kind == 2) tile_copy_out((u16*)(ws + OFF_VT0 + (size_t)br * 16 * MiB) + ((size_t)(brow >> 12) * 512 + cb) * SEQ + (brow & (SEQ - 1)), SEQ);
      else tile_copy_out((u16*)(ws + OFF_G0 + (size_t)br * 16 * MiB) + (size_t)brow * 512 + cb, 512);
    } else __syncthreads();
  }
}

DI unsigned umap(float f) { unsigned u = __float_as_uint(f); return (u & 0x80000000u) ? ~u : (u | 0x80000000u); }

struct SelIn { bf16x8 aq[2][4]; float wv[2][16]; };
DI void select_load(const Params& p, int b, int t0, SelIn& in) {
  const int tid = ltid(), lane = tid & 63, r = lane & 31, half = lane >> 5;
  const u16* qi = (const u16*)(p.ws + OFF_QI);
  const float* wi = (const float*)(p.ws + OFF_WI);
  const int i_ = (r & 3) | ((r >> 3) << 2), hh = (r >> 2) & 1;
#pragma unroll
  for (int be = 0; be < 2; ++be) {
    const int qloc = 4 * be + 2 * hh + (i_ >> 3), head = i_ & 7;
    const u16* src = qi + (size_t)(b * SEQ + t0 + qloc) * 512 + head * 64 + 8 * half;
#pragma unroll
    for (int ks = 0; ks < 4; ++ks) in.aq[be][ks] = *(const bf16x8*)(src + 16 * ks);
  }
#pragma unroll
  for (int be = 0; be < 2; ++be)
#pragma unroll
    for (int e = 0; e < 2; ++e) {
      const float4* w4 = (const float4*)(wi + (size_t)(b * SEQ + t0 + 4 * be + 2 * half + e) * 8);
      const float4 a = w4[0], c = w4[1];
      in.wv[be][8 * e + 0] = a.x; in.wv[be][8 * e + 1] = a.y; in.wv[be][8 * e + 2] = a.z; in.wv[be][8 * e + 3] = a.w;
      in.wv[be][8 * e + 4] = c.x; in.wv[be][8 * e + 5] = c.y; in.wv[be][8 * e + 6] = c.z; in.wv[be][8 * e + 7] = c.w;
    }
}
DI void select_item(const Params& p, int b, int t0, SelIn& in, bool has_next, int nb, int nt0, unsigned long long& acc1, unsigned long long& acc2) {
  const unsigned long long tq0 = (PROBE_K >= 20) ? __builtin_amdgcn_s_memrealtime() : 0ull;
  extern __shared__ __attribute__((aligned(16))) char smem[];
  unsigned* sc = (unsigned*)smem;
  __shared__ __attribute__((aligned(16))) unsigned clist[8][64];
  const int tid = ltid(), wave = tid >> 6, lane = tid & 63, r = lane & 31, half = lane >> 5;
  const u16* ki = (const u16*)(p.ws + OFF_KI);
  const int nkt = t0 / 32 + 1;
  {
    auto& aq = in.aq; auto& wv = in.wv;
    for (int kt0 = wave; kt0 < nkt; kt0 += 32) {
      bf16x8 bk[4][4];
#pragma unroll
      for (int u = 0; u < 4; ++u) {
        const int kt = kt0 + 8 * u;
        if (kt < nkt) {
          const u16* ksrc = ki + (size_t)(b * SEQ + 32 * kt + r) * 64 + 8 * half;
#pragma unroll
          for (int ks = 0; ks < 4; ++ks) bk[u][ks] = *(const bf16x8*)(ksrc + 16 * ks);
        }
      }
#pragma unroll
      for (int u = 0; u < 4; ++u) {
        const int kt = kt0 + 8 * u;
        if (kt < nkt) {
          const int key = 32 * kt + r;
#pragma unroll
          for (int be = 0; be < 2; ++be) {
            f32x16 c;
#pragma unroll
            for (int i = 0; i < 16; ++i) c[i] = 0.f;
#pragma unroll
            for (int ks = 0; ks < 4; ++ks) c = __builtin_amdgcn_mfma_f32_32x32x16_bf16(aq[be][ks], bk[u][ks], c, 0, 0, 0);
#pragma unroll
            for (int e = 0; e < 2; ++e) {
              float sv = 0.f;
#pragma unroll
              for (int i = 0; i < 8; ++i) sv = fmaf(wv[be][8 * e + i], fmaxf(c[8 * e + i], 0.f), sv);
              if (sv == 0.f) sv = 0.f;
              const int q = 4 * be + 2 * half + e;
              sc[q * 4128 + key] = (key <= t0 + q) ? umap(sv) : 0u;
            }
          }
        }
      }
    }
  }
  if (has_next) select_load(p, nb, nt0, in);
  __syncthreads();
  const unsigned long long tq1 = (PROBE_K >= 20) ? __builtin_amdgcn_s_memrealtime() : 0ull;
  {
    const int t = t0 + wave;
    const int L = t + 1;
    const int nvalid = 32 * nkt;
    const int nreg = (nvalid + 63) >> 6;
    unsigned v[64];
#pragma unroll
    for (int j = 0; j < 64; ++j) v[j] = 0u;
    const int ngrp = (nreg + 15) >> 4;
#pragma unroll
    for (int gq = 0; gq < 4; ++gq) {
      if (gq < ngrp) {
#pragma unroll
        for (int jj = 0; jj < 16; ++jj) { const int j = gq * 16 + jj; const int key = 64 * j + lane; if (key < nvalid) v[j] = sc[wave * 4128 + key]; }
      }
    }
    unsigned thr = 1u;
    int need_eq = -1;
    if (L > 256) {
      unsigned P = 0u; bool done = false;
      int n_ge = 64 * 64, c_above = 0;
      int bit = 31;
      for (; bit >= 0; --bit) {
        const unsigned cand = P | (1u << bit);
        int cl = 0;
#pragma unroll
        for (int gq = 0; gq < 4; ++gq) {
          if (gq < ngrp) {
#pragma unroll
            for (int jj = 0; jj < 16; ++jj) cl += (v[gq * 16 + jj] >= cand) ? 1 : 0;
          }
        }
        const int c = wave_sum_dpp(cl);
        if (c >= 256) { P = cand; n_ge = c; } else c_above = c;
        if (c == 256) { done = true; break; }
        if (n_ge - c_above <= 64) { --bit; break; }
      }
      if (!done && bit >= 0) {
        unsigned* cl = clist[wave];
        int base = 0;
        const unsigned sh = (unsigned)(bit + 1);
#pragma unroll
        for (int gq = 0; gq < 4; ++gq) {
          if (gq < ngrp) {
#pragma unroll
            for (int jj = 0; jj < 16; ++jj) {
              const unsigned x = v[gq * 16 + jj];
              const bool und = ((x ^ P) >> sh) == 0u;
              const unsigned long long m = __ballot(und);
              if (und) cl[base + __popcll(m & ((1ull << lane) - 1ull))] = x;
              base += __popcll(m);
            }
          }
        }
        const unsigned vc = (lane < base) ? cl[lane] : 0u;
        for (; bit >= 0; --bit) {
          const unsigned cand = P | (1u << bit);
          const int c = c_above + __popcll(__ballot(vc >= cand));
          if (c >= 256) P = cand;
          if (c == 256) { done = true; break; }
        }
      }
      thr = P;
      if (!done) {
        int cge = 0, cgt = 0;
#pragma unroll
        for (int j = 0; j < 64; ++j) { cge += __popcll(__ballot(v[j] >= P)); cgt += __popcll(__ballot(v[j] > P)); }
        if (cge > 256) need_eq = 256 - cgt;
      }
    }
    unsigned long long mine = 0ull;
    if (need_eq < 0) {
#pragma unroll
      for (int gq = 0; gq < 4; ++gq) {
        if (gq < ngrp) {
#pragma unroll
          for (int jj = 0; jj < 16; ++jj) { const int j = gq * 16 + jj; const unsigned long long bm = __ballot(v[j] >= thr); if (lane == j) mine = bm; }
        }
      }
    } else {
      int eq_seen = 0;
#pragma unroll
      for (int j = 0; j < 64; ++j) {
        const bool eq = v[j] == thr;
        const unsigned long long eb = __ballot(eq);
        const int rank = eq_seen + __popcll(eb & ((1ull << lane) - 1ull));
        const bool sel = (v[j] > thr) || (eq && rank < need_eq);
        eq_seen += __popcll(eb);
        const unsigned long long bm = __ballot(sel);
        if (lane == j) mine = bm;
      }
    }
    unsigned long long* mrow = (unsigned long long*)(p.ws + OFF_MASK) + (size_t)(b * SEQ + t) * 64;
    mrow[lane] = mine;
  }
  __syncthreads();
  if (PROBE_K >= 20) { const unsigned long long tq2 = __builtin_amdgcn_s_memrealtime(); acc1 += tq1 - tq0; acc2 += tq2 - tq1; }
}

DI void phase_select(const Params& p, int layer) {
  const int g = blockIdx.x, G = gridDim.x;
  const int tid = ltid(), wave = tid >> 6, lane = tid & 63;
  __shared__ __attribute__((aligned(16))) float red[8][64];
  for (int it = g * 8 + wave; it < NBATCH * NH; it += G * 8) {
    const int b = it >> 3, h = it & 7;
    const float* lf = (const float*)(p.ws + OFF_LF) + (size_t)b * SEQ * 8 + h;
    float* cs = (float*)(p.ws + OFF_CS) + (size_t)it * SEQ;
    float carry = 0.f;
#pragma unroll 8
    for (int c = 0; c < 64; ++c) {
      float v = lf[(size_t)(64 * c + lane) * 8];
      v += __int_as_float(__builtin_amdgcn_update_dpp(0, __float_as_int(v), 0x111, 0xF, 0xF, false));
      v += __int_as_float(__builtin_amdgcn_update_dpp(0, __float_as_int(v), 0x112, 0xF, 0xF, false));
      v += __int_as_float(__builtin_amdgcn_update_dpp(0, __float_as_int(v), 0x114, 0xF, 0xF, false));
      v += __int_as_float(__builtin_amdgcn_update_dpp(0, __float_as_int(v), 0x118, 0xF, 0xF, false));
      const float t0 = __int_as_float(__builtin_amdgcn_readlane(__float_as_int(v), 15));
      const float t1 = __int_as_float(__builtin_amdgcn_readlane(__float_as_int(v), 31));
      const float t2 = __int_as_float(__builtin_amdgcn_readlane(__float_as_int(v), 47));
      const float t3 = __int_as_float(__builtin_amdgcn_readlane(__float_as_int(v), 63));
      const float add = carry + (lane >= 48 ? (t0 + t1) + t2 : lane >= 32 ? t0 + t1 : lane >= 16 ? t0 : 0.f);
      cs[64 * c + lane] = (v + add) * LOG2E;
      carry += ((t0 + t1) + t2) + t3;
    }
  }
  for (int task = g * 8 + wave; task < 2 * NBATCH * NH * 64; task += G * 8) {
    const int which = task >> 11, rem = task & 2047, bh = rem >> 6, g64 = rem & 63;
    const u16* base = (const u16*)(p.ws + OFF_Q0 + (size_t)2 * 32 * MiB + (which ? 16 * MiB : 0));
    const u16* row = base + ((size_t)(bh >> 3) * SEQ + g64 * 64 + lane) * 512 + (bh & 7) * 64;
    float n2 = 0.f, sd = 0.f;
#pragma unroll
    for (int c8 = 0; c8 < 8; ++c8) {
      const u32x4 w = *(const u32x4*)(row + 8 * c8);
      u32x4 wk = w;
      if (which == 0) wk = *(const u32x4*)(row + 8 * MiB + 8 * c8);
#pragma unroll
      for (int e = 0; e < 4; ++e) {
        const float lo = bf2f(w[e] & 0xffffu), hi = bf2f(w[e] >> 16);
        n2 = fmaf(lo, lo, n2); n2 = fmaf(hi, hi, n2);
        sd = fmaf(lo, bf2f(wk[e] & 0xffffu), sd); sd = fmaf(hi, bf2f(wk[e] >> 16), sd);
      }
    }
#pragma unroll
    for (int o = 32; o > 0; o >>= 1) { n2 = fmaxf(n2, __shfl_xor(n2, o)); sd = fminf(sd, __shfl_xor(sd, o)); }
    if (lane == 0) { ((float*)(p.ws + OFF_NORM))[task] = n2; if (which == 0) ((float*)(p.ws + OFF_NORM))[4096 + rem] = sd; }
  }
  for (int pr = g; pr < 256; pr += G) {
    const int item = pr * 2 + (wave >> 2);
    const int b = item >> 7, h = (item >> 4) & 7, n = item & 15;
    const u16* k = (const u16*)(p.ws + OFF_Q0 + 16 * MiB) + (size_t)(b * SEQ + n * 256 + (wave & 3) * 64) * 512 + h * 64 + lane;
    float s = 0.f;
    for (int i = 0; i < 64; ++i) s += bf2f(k[(size_t)i * 512]);
    red[wave][lane] = s;
    __syncthreads();
    if ((wave & 3) == 0) {
      const float tot = red[wave][lane] + red[wave + 1][lane] + red[wave + 2][lane] + red[wave + 3][lane];
      ((float*)(p.ws + OFF_KMEAN))[(size_t)item * 64 + lane] = tot * (1.f / 256.f);
    }
    __syncthreads();
  }
  unsigned long long acc1 = 0ull, acc2 = 0ull;
  {
    unsigned* ctr = (unsigned*)(p.ws + OFF_BAR) + 16 + layer;
    __shared__ int sel_next;
    if (tid == 0) sel_next = (int)atomicAdd(ctr, 1u);
    __syncthreads();
    int idx = sel_next;
    __syncthreads();
    SelIn in;
    bool have = idx < 2048;
    if (have) select_load(p, idx & 3, (511 - (idx >> 2)) * 8, in);
    while (have) {
      if (tid == 0) sel_next = (int)atomicAdd(ctr, 1u);
      __syncthreads();
      const int nidx = sel_next;
      const bool has_next = nidx < 2048;
      select_item(p, idx & 3, (511 - (idx >> 2)) * 8, in, has_next, nidx & 3, (511 - (nidx >> 2)) * 8, acc1, acc2);
      have = has_next; idx = nidx;
    }
  }
  if (PROBE_K == 20 || PROBE_K == 21) {
    const unsigned long long w = (PROBE_K == 20) ? acc1 : acc2;
    const unsigned long long t1 = __builtin_amdgcn_s_memrealtime();
    while (__builtin_amdgcn_s_memrealtime() - t1 < w) __builtin_amdgcn_s_sleep(8);
  }
}

DI int perm23(int r) { return (r & ~12) | ((r & 4) << 1) | ((r & 8) >> 1); }

DI void attn_item(const Params& p, int br, int b, int h, int qb) {
  extern __shared__ __attribute__((aligned(16))) char smem[];
  u16* Ks = (u16*)smem;
  u16* Vs = (u16*)(smem + 4 * 64 * 144);
  float* cks = (float*)(smem + 8 * 64 * 144);
  float* kmS = (float*)(smem + 8 * 64 * 144 + 1024);
  const int tid = ltid(), wave = tid >> 6, lane = tid & 63, r = lane & 31, half = lane >> 5;
  const u16* Qp = (const u16*)(p.ws + OFF_Q0 + (size_t)br * 32 * MiB);
  const u16* Kp = (const u16*)(p.ws + OFF_Q0 + (size_t)br * 32 * MiB + 16 * MiB);
  const u16* VTp = (const u16*)(p.ws + OFF_VT0 + (size_t)br * 16 * MiB) + (size_t)(b * 8 + h) * 64 * SEQ;
  u16* Gp = (u16*)(p.ws + OFF_G0 + (size_t)br * 16 * MiB);
  const float* csrow = (const float*)(p.ws + OFF_CS) + (size_t)(b * 8 + h) * SEQ;
  const unsigned* maskp = (const unsigned*)(p.ws + OFF_MASK);
  const int qpos = qb * 256 + wave * 32 + r;
  const size_t qtok = (size_t)b * SEQ + qpos;

  bf16x8 qf[4];
#pragma unroll
  for (int ks = 0; ks < 4; ++ks) qf[ks] = *(const bf16x8*)(Qp + qtok * 512 + h * 64 + 16 * ks + 8 * half);

  unsigned selmask = 0u;
  if (br == 0 && qb > 0) {
    if (qb <= 3) selmask = (1u << qb) - 1u;
    else {
      const float* kmg = (const float*)(p.ws + OFF_KMEAN) + (size_t)(b * 8 + h) * 16 * 64;
      __syncthreads();
      kmS[tid] = kmg[tid]; kmS[tid + 512] = kmg[tid + 512];
      __syncthreads();
      const float* km = kmS;
      float qv[64];
      const u16* qrow = Qp + qtok * 512 + h * 64;
#pragma unroll
      for (int c8 = 0; c8 < 8; ++c8) {
        const u32x4 w = *(const u32x4*)(qrow + 8 * c8);
#pragma unroll
        for (int e = 0; e < 4; ++e) { qv[8 * c8 + 2 * e] = bf2f(w[e] & 0xffffu); qv[8 * c8 + 2 * e + 1] = bf2f(w[e] >> 16); }
      }
      float v0 = -INFINITY, v1 = -INFINITY, v2 = -INFINITY; int i0 = 0, i1 = 0, i2 = 0;
      for (int n = 0; n < qb; ++n) {
        float gsc = 0.f;
#pragma unroll
        for (int d4 = 0; d4 < 16; ++d4) {
          const float4 kk4 = *(const float4*)(km + n * 64 + 4 * d4);
          gsc = fmaf(qv[4 * d4], kk4.x, gsc); gsc = fmaf(qv[4 * d4 + 1], kk4.y, gsc); gsc = fmaf(qv[4 * d4 + 2], kk4.z, gsc); gsc = fmaf(qv[4 * d4 + 3], kk4.w, gsc);
        }
        if (gsc > v0) { v2 = v1; i2 = i1; v1 = v0; i1 = i0; v0 = gsc; i0 = n; }
        else if (gsc > v1) { v2 = v1; i2 = i1; v1 = gsc; i1 = n; }
        else if (gsc > v2) { v2 = gsc; i2 = n; }
      }
      selmask = (1u << i0) | (1u << i1) | (1u << i2);
    }
  }

  const int nkt = (qb + 1) * 4;
  const int my_last = qb * 4 + (wave >> 1);
  const int lrow = tid >> 3, lchunk = tid & 7;
  const u16* ksrc = Kp + ((size_t)b * SEQ + lrow) * 512 + h * 64 + lchunk * 8;
  const u16* vsrc = VTp + (size_t)lrow * SEQ + lchunk * 8;
  const int lds_off = lrow * 72 + lchunk * 8;
  const int kr = perm23(r);
  const int kfo = kr * 72 + 8 * half;
  const int vfo = r * 72 + 8 * half;

  int kp_start = 0;
  if (br == 2 && qb > 0) {
    const float* nq = (const float*)(p.ws + OFF_NORM) + (size_t)(b * 8 + h) * 64;
    const float* nk = nq + 2048;
    const float q2 = fmaxf(fmaxf(nq[4 * qb], nq[4 * qb + 1]), fmaxf(nq[4 * qb + 2], nq[4 * qb + 3]));
    const float* sdm = nq + 4096;
    const float smin = fminf(fminf(sdm[4 * qb], sdm[4 * qb + 1]), fminf(sdm[4 * qb + 2], sdm[4 * qb + 3]));
    const int npast = 2 * qb;
    bool ok = false;
    if (lane < npast) {
      const int kpl = 2 * lane;
      const float k2 = fmaxf(nk[kpl], nk[kpl + 1]);
      const float bound = sqrtf(q2) * sqrtf(k2) * 1.01f - smin + 0.05f;
      const float dmin = csrow[64 * (kpl + 2) - 1] - csrow[256 * qb];
      ok = (bound - dmin < -40.f);
    }
    const unsigned long long okm = __ballot(ok);
    const int first_not = __builtin_ctzll(~okm);
    kp_start = 2 * first_not;
  }
  {
    const int s0 = kp_start & 2;
    const u32x4 k0 = *(const u32x4*)(ksrc + (size_t)kp_start * 64 * 512);
    const u32x4 v0 = *(const u32x4*)(vsrc + kp_start * 64);
    const u32x4 k1 = *(const u32x4*)(ksrc + (size_t)(kp_start + 1) * 64 * 512);
    const u32x4 v1 = *(const u32x4*)(vsrc + (kp_start + 1) * 64);
    float c0 = 0.f;
    if (br == 2 && tid < 128) c0 = csrow[kp_start * 64 + tid];
    __syncthreads();
    *(u32x4*)(Ks + s0 * 64 * 72 + lds_off) = k0;
    *(u32x4*)(Vs + s0 * 64 * 72 + lds_off) = v0;
    *(u32x4*)(Ks + (s0 + 1) * 64 * 72 + lds_off) = k1;
    *(u32x4*)(Vs + (s0 + 1) * 64 * 72 + lds_off) = v1;
    if (br == 2 && tid < 128) cks[s0 * 64 + tid] = c0;
    __syncthreads();
  }

  f32x16 o0, o1;
#pragma unroll
  for (int i = 0; i < 16; ++i) { o0[i] = 0.f; o1[i] = 0.f; }
  float mrun = -1e30f, lrun = 0.f;

  auto tile2 = [&](int kp, int sb, const u32x4& mw) {
    f32x16 s[4];
#pragma unroll
    for (int t = 0; t < 4; ++t)
#pragma unroll
      for (int i = 0; i < 16; ++i) s[t][i] = 0.f;
#pragma unroll
    for (int t = 0; t < 2; ++t) {
      const u16* Kb = Ks + (sb + t) * 64 * 72 + kfo;
      bf16x8 kf[8];
#pragma unroll
      for (int ks = 0; ks < 4; ++ks) { kf[2 * ks] = *(const bf16x8*)(Kb + 16 * ks); kf[2 * ks + 1] = *(const bf16x8*)(Kb + 32 * 72 + 16 * ks); }
      __builtin_amdgcn_sched_barrier(0);
#pragma unroll
      for (int ks = 0; ks < 4; ++ks) {
        s[2 * t] = __builtin_amdgcn_mfma_f32_32x32x16_bf16(kf[2 * ks], qf[ks], s[2 * t], 0, 0, 0);
        s[2 * t + 1] = __builtin_amdgcn_mfma_f32_32x32x16_bf16(kf[2 * ks + 1], qf[ks], s[2 * t + 1], 0, 0, 0);
      }
      __builtin_amdgcn_sched_barrier(0);
    }
    if (br == 2) {
      const float* cb = cks + sb * 64;
#pragma unroll
      for (int t = 0; t < 4; ++t)
#pragma unroll
        for (int i = 0; i < 16; ++i) s[t][i] -= cb[32 * t + (i & 7) + 8 * half + 16 * (i >> 3)];
    }
    bool lane_on = true;
    const bool diag = (kp >= qb * 4);
    if (br != 1 && diag) {
#pragma unroll
      for (int t = 0; t < 4; ++t) {
        const int nv = qpos - 64 * kp - 32 * t + 1;
        unsigned w = nv >= 32 ? 0xffffffffu : (nv <= 0 ? 0u : ((1u << nv) - 1u));
        w >>= (8 * half);
#pragma unroll
        for (int i = 0; i < 16; ++i) s[t][i] = ((w >> ((i & 7) + 16 * (i >> 3))) & 1u) ? s[t][i] : -INFINITY;
      }
    } else if (br == 0) {
      lane_on = (selmask >> (kp >> 2)) & 1u;
    }
    float tmax = -INFINITY;
#pragma unroll
    for (int i = 0; i < 16; ++i) tmax = fmaxf(fmaxf(tmax, fmaxf(s[0][i], s[1][i])), fmaxf(s[2][i], s[3][i]));
    tmax = fmaxf(tmax, __shfl_xor(tmax, 32));
    if (!lane_on) tmax = -INFINITY;
    const float mnew = fmaxf(mrun, tmax);
    const float alpha = fast_exp2(mrun - mnew);
    mrun = mnew;
    const float sub = lane_on ? mnew : INFINITY;
#pragma unroll
    for (int t = 0; t < 4; ++t)
#pragma unroll
      for (int i = 0; i < 16; ++i) s[t][i] = fast_exp2(s[t][i] - sub);
    if (br == 1) {
#pragma unroll
      for (int t = 0; t < 4; ++t) {
        const unsigned w = mw[t] >> (8 * half);
#pragma unroll
        for (int i = 0; i < 16; ++i) s[t][i] = __uint_as_float(__float_as_uint(s[t][i]) & (unsigned)(-(int)((w >> ((i & 7) + 16 * (i >> 3))) & 1u)));
      }
    }
    float psum = 0.f;
#pragma unroll
    for (int i = 0; i < 16; ++i) psum += (s[0][i] + s[1][i]) + (s[2][i] + s[3][i]);
    lrun = lrun * alpha + psum;
    if (__ballot(alpha != 1.f) != 0ull) {
#pragma unroll
      for (int i = 0; i < 16; ++i) { o0[i] *= alpha; o1[i] *= alpha; }
    }
#pragma unroll
    for (int t = 0; t < 2; ++t) {
      const u16* Vb = Vs + (sb + t) * 64 * 72 + vfo;
      bf16x8 vf[8];
#pragma unroll
      for (int kk = 0; kk < 4; ++kk) { vf[2 * kk] = *(const bf16x8*)(Vb + 16 * kk); vf[2 * kk + 1] = *(const bf16x8*)(Vb + 32 * 72 + 16 * kk); }
      bf16x8 pfr[4];
#pragma unroll
      for (int kk = 0; kk < 4; ++kk) {
        const f32x16& sv = s[2 * t + (kk >> 1)];
        const int e = 8 * (kk & 1);
        u32x4 pw;
        pw[0] = pk2(sv[e + 0], sv[e + 1]); pw[1] = pk2(sv[e + 2], sv[e + 3]); pw[2] = pk2(sv[e + 4], sv[e + 5]); pw[3] = pk2(sv[e + 6], sv[e + 7]);
        pfr[kk] = __builtin_bit_cast(bf16x8, pw);
      }
      __builtin_amdgcn_sched_barrier(0);
#pragma unroll
      for (int kk = 0; kk < 4; ++kk) {
        o0 = __builtin_amdgcn_mfma_f32_32x32x16_bf16(vf[2 * kk], pfr[kk], o0, 0, 0, 0);
        o1 = __builtin_amdgcn_mfma_f32_32x32x16_bf16(vf[2 * kk + 1], pfr[kk], o1, 0, 0, 0);
      }
      __builtin_amdgcn_sched_barrier(0);
    }
  };

  u32x4 mw4; mw4[0] = mw4[1] = mw4[2] = mw4[3] = 0u;
  if (br == 1) mw4 = *(const u32x4*)(maskp + qtok * 128);
  for (int kp = kp_start; kp < nkt; kp += 2) {
    const int sb = kp & 2;
    const bool more = (kp + 2 < nkt);
    u32x4 kra, krb, vra, vrb, mwn = mw4; float creg = 0.f;
    if (more) {
      kra = *(const u32x4*)(ksrc + (size_t)(kp + 2) * 64 * 512);
      krb = *(const u32x4*)(ksrc + (size_t)(kp + 3) * 64 * 512);
      vra = *(const u32x4*)(vsrc + (kp + 2) * 64);
      vrb = *(const u32x4*)(vsrc + (kp + 3) * 64);
      if (br == 2 && tid < 128) creg = csrow[(kp + 2) * 64 + tid];
      if (br == 1) mwn = *(const u32x4*)(maskp + qtok * 128 + 2 * (kp + 2));
    }
    if (kp <= my_last) tile2(kp, sb, mw4);
    if (more) {
      const int nb2 = sb ^ 2;
      *(u32x4*)(Ks + nb2 * 64 * 72 + lds_off) = kra;
      *(u32x4*)(Ks + (nb2 + 1) * 64 * 72 + lds_off) = krb;
      *(u32x4*)(Vs + nb2 * 64 * 72 + lds_off) = vra;
      *(u32x4*)(Vs + (nb2 + 1) * 64 * 72 + lds_off) = vrb;
      if (br == 2 && tid < 128) cks[nb2 * 64 + tid] = creg;
    }
    mw4 = mwn;
    __syncthreads();
  }

  const float ltot = lrun + __shfl_xor(lrun, 32);
  const float inv = 1.f / ltot;
  u16* grow = Gp + qtok * 512 + h * 64;
#pragma unroll
  for (int db = 0; db < 2; ++db)
#pragma unroll
    for (int g4 = 0; g4 < 4; ++g4) {
      const int d0 = 32 * db + 8 * g4 + 4 * half;
      const u32x2 gw = *(const u32x2*)(grow + d0);
      float a[4];
#pragma unroll
      for (int e = 0; e < 4; ++e) a[e] = (db == 0 ? o0[4 * g4 + e] : o1[4 * g4 + e]) * inv;
      u32x2 ow;
      ow[0] = pk2(a[0] * bf2f(gw[0] & 0xffffu), a[1] * bf2f(gw[0] >> 16));
      ow[1] = pk2(a[2] * bf2f(gw[1] & 0xffffu), a[3] * bf2f(gw[1] >> 16));
      *(u32x2*)(grow + d0) = ow;
    }
}

DI void phase_attn(const Params& p, int layer) {
  constexpr int NI = 3 * NBATCH * NH * 16;
  unsigned* ctr = (unsigned*)(p.ws + OFF_BAR) + 8 + layer;
  __shared__ int cur_item;
  for (;;) {
    if (threadIdx.x == 0) cur_item = (int)atomicAdd(ctr, 1u);
    __syncthreads();
    const int idx = cur_item;
    __syncthreads();
    if (idx >= NI) break;
    const int qb = 15 - idx / 96, rem = idx % 96;
    const int bsel = rem >> 5, bh = rem & 31;
    const int br = bsel == 0 ? 1 : (bsel == 1 ? 2 : 0);
    attn_item(p, br, bh >> 3, bh & 7, qb);
  }
}

DI void phase_merge(const Params& p) {
  const u16* xb = (const u16*)(p.ws + OFF_XB);
  const u16* wm_t = (const u16*)(p.ws + OFF_WIN) + (size_t)N1 * DM;
  const u16* wbr_t = (const u16*)(p.ws + OFF_WBR);
  const float* rstd = (const float*)(p.ws + OFF_RSTD);
  u16* merged = (u16*)(p.ws + OFF_MERGED);
  char* scr = p.ws + OFF_SCR + (size_t)blockIdx.x * 384 * 1024;
  u32x2* sig = (u32x2*)scr;
  f32x4* part = (f32x4*)(scr + 128 * 1024);
  const int tid = ltid();
  extern __shared__ __attribute__((aligned(16))) char smem[];
  u16* lds16 = (u16*)smem;
  for (int u = blockIdx.x; u < 256; u += gridDim.x) {
    const int pn = u / 64, pm = u % 64;
    const int brow = pm * 256, bcol = pn * 256;
    for (int nb = 0; nb < 3; ++nb) {
      struct PreG { float rs[4]; };
      gemm_unit(xb, DM, wm_t + (size_t)nb * DM * DM, DM, DM, brow, bcol,
        [&](int ai, int m, int row0, int col0) {
          PreG q; asm volatile("" : "+v"(row0));
#pragma unroll
          for (int j = 0; j < 4; ++j) q.rs[j] = rstd[row0 + j];
          return q;
        },
        [&](int ai, int bj, int m, int n, f32x4 a, int row0, int col, const PreG& q) {
          float v[4];
#pragma unroll
          for (int j = 0; j < 4; ++j) { const float z = a[j] * q.rs[j]; v[j] = __builtin_amdgcn_rcpf(1.f + __expf(-z)); }
          u32x2 o; o[0] = pk2(v[0], v[1]); o[1] = pk2(v[2], v[3]);
          int t_ = tid; asm volatile("" : "+v"(t_));
          sig[(((ai * 2 + bj) * 4 + m) * 2 + n) * 512 + t_] = o;
        });
      const u16* gp = (const u16*)(p.ws + OFF_G0 + (size_t)nb * 16 * MiB);
      struct PreY { u32x2 sg[4]; f32x4 pt[4]; };
      gemm_unit(gp, WID, wbr_t + (size_t)nb * DM * WID, WID, WID, brow, bcol,
        [&](int ai, int m, int row0, int col0) {
          PreY q; int t_ = tid; asm volatile("" : "+v"(t_));
#pragma unroll
          for (int c = 0; c < 4; ++c) {
            const int slot = (((ai * 2 + (c >> 1)) * 4 + m) * 2 + (c & 1)) * 512 + t_;
            q.sg[c] = sig[slot];
            if (nb > 0) q.pt[c] = part[slot]; else { q.pt[c][0] = 0.f; q.pt[c][1] = 0.f; q.pt[c][2] = 0.f; q.pt[c][3] = 0.f; }
          }
          return q;
        },
        [&](int ai, int bj, int m, int n, f32x4 a, int row0, int col, const PreY& q) {
          int t_ = tid; asm volatile("" : "+v"(t_));
          const int slot = (((ai * 2 + bj) * 4 + m) * 2 + n) * 512 + t_;
          const u32x2 sg = q.sg[bj * 2 + n];
          f32x4 v;
          v[0] = a[0] * bf2f(sg[0] & 0xffffu); v[1] = a[1] * bf2f(sg[0] >> 16);
          v[2] = a[2] * bf2f(sg[1] & 0xffffu); v[3] = a[3] * bf2f(sg[1] >> 16);
          v += q.pt[bj * 2 + n];
          if (nb < 2) part[slot] = v;
          else {
#pragma unroll
            for (int j = 0; j < 4; ++j) lds16[(row0 - brow + j) * EPI_LD + (col - bcol)] = f2bf(v[j]);
          }
        });
    }
    tile_copy_out(merged + (size_t)brow * DM + bcol, DM);
  }
}

DI void phase_out(const Params& p, int layer) {
  const u16* merged = (const u16*)(p.ws + OFF_MERGED);
  const u16* wout_t = (const u16*)(p.ws + OFF_WOUT);
  const float* resid = layer == 0 ? p.x : p.out;
  float* out = p.out;
  for (int u = blockIdx.x; u < 256; u += gridDim.x) {
    const int pn = u / 64, pm = u % 64;
    struct PreO { float r[4][4]; };
    gemm_unit(merged, DM, wout_t, DM, DM, pm * 256, pn * 256,
      [&](int ai, int m, int row0, int col0) {
        PreO q; asm volatile("" : "+v"(row0), "+v"(col0));
#pragma unroll
        for (int c = 0; c < 4; ++c)
#pragma unroll
          for (int j = 0; j < 4; ++j) q.r[c][j] = resid[(size_t)(row0 + j) * DM + col0 + (c >> 1) * 128 + (c & 1) * 16];
        return q;
      },
      [&](int ai, int bj, int m, int n, f32x4 a, int row0, int col, const PreO& q) {
#pragma unroll
        for (int j = 0; j < 4; ++j) { const size_t o = (size_t)(row0 + j) * DM + col; out[o] = q.r[bj * 2 + n][j] + a[j]; }
      });
  }
}

DI void phase_final(const Params& p) {
  const int tid_ = ltid(), wave = tid_ >> 6, lane = tid_ & 63;
  const float4* g4 = (const float4*)p.final_gain;
  for (int row = blockIdx.x * 8 + wave; row < T_TOK; row += gridDim.x * 8) {
    float4* s4 = (float4*)(p.out + (size_t)row * DM);
    float4 v[4]; float ss = 0.f;
#pragma unroll
    for (int i = 0; i < 4; ++i) { v[i] = s4[lane + 64 * i]; ss += v[i].x * v[i].x + v[i].y * v[i].y + v[i].z * v[i].z + v[i].w * v[i].w; }
    ss = wave_sum(ss);
    const float rs = rsqrtf(ss * (1.0f / DM) + 1e-6f);
#pragma unroll
    for (int i = 0; i < 4; ++i) {
      const float4 gg = g4[lane + 64 * i];
      float4 o; o.x = v[i].x * rs * gg.x; o.y = v[i].y * rs * gg.y; o.z = v[i].z * rs * gg.z; o.w = v[i].w * rs * gg.w;
      s4[lane + 64 * i] = o;
    }
  }
}


#define XB_TMO      128
#define XB_XCNT(j)  (256  + 64 * (j))
#define XB_XSUB(j)  (1280 + 64 * (j))
#define XB_XGEN(j)  (2304 + 64 * (j))
#define XB_TOP      3328
#define XB_TOPGEN   3392
#define XCD_BAR_WORDS 3456
#define XB_SPIN_CAP (1u << 22)
#define LAS __attribute__((address_space(3)))
DI unsigned xb_ld(unsigned* p)              { return __hip_atomic_load(p, __ATOMIC_RELAXED, __HIP_MEMORY_SCOPE_AGENT); }
DI unsigned xb_add(unsigned* p, unsigned v) { return __hip_atomic_fetch_add(p, v, __ATOMIC_RELAXED, __HIP_MEMORY_SCOPE_AGENT); }
DI unsigned xb_xcc_id() { return (unsigned)__builtin_amdgcn_s_getreg((3 << 11) | 20) & 0xFu; }
#define XB_SPIN(cond, bar) do { unsigned _sp = 0; while (cond) { __builtin_amdgcn_s_sleep(1); \
    if ((++_sp & 255u) == 0u) { if (xb_ld(&(bar)[XB_TMO])) break; if (_sp > XB_SPIN_CAP) { atomicAdd(&(bar)[XB_TMO], 1u); break; } } } } while (0)
struct XcdBarrier { unsigned* bar; unsigned x; volatile LAS unsigned* st; };
DI XcdBarrier xcd_barrier_post(unsigned* bar, volatile LAS unsigned* st) {
  XcdBarrier b; b.bar = bar; b.x = xb_xcc_id(); b.st = st;
  if (threadIdx.x == 0) (void)xb_add(&bar[XB_XCNT(b.x)], 1u);
  return b;
}
DI void xcd_barrier_complete(unsigned* bar, unsigned x, unsigned& nloc, unsigned& nx) {
  const unsigned G = gridDim.x * gridDim.y * gridDim.z;
  unsigned sum, cnt, mine, sp = 0u;
  for (;;) {
    sum = 0u; cnt = 0u; mine = 0u;
#pragma unroll
    for (unsigned j = 0; j < 16; ++j) { const unsigned c = xb_ld(&bar[XB_XCNT(j)]); sum += c; cnt += (c > 0u) ? 1u : 0u; mine = (j == x) ? c : mine; }
    if (sum == G) break;
    __builtin_amdgcn_s_sleep(1);
    if ((++sp & 255u) == 0u) { if (xb_ld(&bar[XB_TMO])) break; if (sp > XB_SPIN_CAP) { atomicAdd(&bar[XB_TMO], 1u); break; } }
  }
  nloc = mine > 0u ? mine : 1u; nx = cnt > 0u ? cnt : 1u;
}
DI void xcd_barrier(const XcdBarrier& b) {
  asm volatile("s_waitcnt vmcnt(0)" ::: "memory");
  __syncthreads();
  if (threadIdx.x == 0) {
    unsigned* bar = b.bar;
    __builtin_amdgcn_s_waitcnt(0);
    unsigned nloc = b.st[0], nx = b.st[1];
    if (nloc == 0u) { xcd_barrier_complete(bar, b.x, nloc, nx); b.st[0] = nloc; b.st[1] = nx; }
    const unsigned old = xb_add(&bar[XB_XSUB(b.x)], 1u);
    const unsigned gen = old / nloc;
    if (old + 1u == (gen + 1u) * nloc) {
      __builtin_amdgcn_fence(__ATOMIC_RELEASE, "agent");
      asm volatile("s_waitcnt vmcnt(0)" ::: "memory");
      const unsigned og = xb_add(&bar[XB_TOP], 1u);
      const unsigned tg = og / nx;
      if (og + 1u == (tg + 1u) * nx) xb_add(&bar[XB_TOPGEN], 1u);
      else XB_SPIN(xb_ld(&bar[XB_TOPGEN]) == tg, bar);
      __builtin_amdgcn_fence(__ATOMIC_ACQUIRE, "agent");
      xb_add(&bar[XB_XGEN(b.x)], 1u);
      asm volatile("s_waitcnt vmcnt(0)" ::: "memory");
    } else {
      XB_SPIN(xb_ld(&bar[XB_XGEN(b.x)]) == gen, bar);
      __builtin_amdgcn_fence(__ATOMIC_ACQUIRE, "agent");
      asm volatile("s_waitcnt vmcnt(0)" ::: "memory");
    }
  }
  __syncthreads();
}

__global__ void __launch_bounds__(NTHR) mega(Params p, int ph_lo, int ph_hi) {
  cg::grid_group grid = cg::this_grid();
  __shared__ uint4 xb_words;
  if (threadIdx.x == 0) xb_words = make_uint4(0u, 0u, 0u, 0u);
  __syncthreads();
  XcdBarrier xb = xcd_barrier_post((unsigned*)(p.ws + OFF_BAR), (volatile LAS unsigned*)&xb_words);
  for (int ph = ph_lo; ph < ph_hi; ++ph) {
    const unsigned long long t_ph0 = (PROBE_K >= 0) ? __builtin_amdgcn_s_memrealtime() : 0ull;
    if (ph == 12) phase_final(p);
    else {
      const int layer = ph / 6, k = ph % 6;
      if (k == 0) phase_prep(p, layer);
      else if (k == 1) phase_proj(p, layer);
      else if (k == 2) phase_select(p, layer);
      else if (k == 3) phase_attn(p, layer);
      else if (k == 4) phase_merge(p);
      else phase_out(p, layer);
    }
    if (PROBE_K >= 0 && ((ph == 12) ? 6 : (ph % 6)) == PROBE_K) {
      const unsigned long long t1 = __builtin_amdgcn_s_memrealtime();
      while (__builtin_amdgcn_s_memrealtime() - t1 < t1 - t_ph0) __builtin_amdgcn_s_sleep(8);
    }
    if (ph + 1 < ph_hi) {
      if (ph_hi > 1000) grid.sync();
      else xcd_barrier(xb);
    }
  }
}

extern "C" void kernel_launch(void* const* d_in, const int* in_sizes, int n_in, void* d_out, int out_size,
                              void* d_ws, size_t ws_size, hipStream_t stream) {
  if (ws_size < WS_NEED) { fprintf(stderr, "workspace too small: %zu < %zu\n", ws_size, (size_t)WS_NEED); return; }
  Params p{};
  p.x = (const float*)d_in[0]; p.norm_gain = (const float*)d_in[1]; p.w_in = (const float*)d_in[2];
  p.fbias = (const float*)d_in[3]; p.w_branch = (const float*)d_in[4]; p.w_out = (const float*)d_in[5];
  p.final_gain = (const float*)d_in[6];
  p.out = (float*)d_out; p.ws = (char*)d_ws;
  (void)hipFuncSetAttribute((const void*)mega, hipFuncAttributeMaxDynamicSharedMemorySize, SMEM_BYTES);
  static int grid = 0;
  if (!grid) {
    int dev = 0, cus = 0, per_cu = 0;
    hipGetDevice(&dev);
    hipDeviceGetAttribute(&cus, hipDeviceAttributeMultiprocessorCount, dev);
    hipOccupancyMaxActiveBlocksPerMultiprocessor(&per_cu, (const void*)mega, NTHR, SMEM_BYTES);
    if (per_cu < 1) per_cu = 1;
    grid = cus;
    if (grid > 256) grid = 256;
  }
  (void)hipMemsetAsync((char*)d_ws + OFF_BAR, 0, 16384, stream);
  int lo = 0, hi = 13;
  void* args[] = {&p, &lo, &hi};
  hipError_t e = hipLaunchCooperativeKernel((const void*)mega, dim3(grid), dim3(NTHR), args, SMEM_BYTES, stream);
  if (e != hipSuccess) fprintf(stderr, "cooperative launch failed: %s (grid %d)\n", hipGetErrorString(e), grid);
}
```

```cpp
#include <hip/hip_runtime.h>
#include <hip/hip_bf16.h>
#include <hip/hip_cooperative_groups.h>
#include <cstdio>
#include <cstdint>
namespace cg = cooperative_groups;

typedef unsigned short u16;
using bf16x8 = __attribute__((ext_vector_type(8))) short;
using f32x4  = __attribute__((ext_vector_type(4))) float;
using f32x16 = __attribute__((ext_vector_type(16))) float;
using u32x2  = __attribute__((ext_vector_type(2))) unsigned;
using u32x4  = __attribute__((ext_vector_type(4))) unsigned;
#define DI __device__ __forceinline__

constexpr int T_TOK = 16384, SEQ = 4096, NBATCH = 4, DM = 1024, NH = 8, HD = 64, WID = 512;
constexpr int D_IN = 9808;
constexpr int N1 = 6912;
constexpr int N1_VALID = 6736;
constexpr int NMERGE = 3072;
constexpr int NWROWS = N1 + NMERGE;
constexpr float QSCALE = 0.125f * 1.4426950408889634f;
constexpr float LOG2E = 1.4426950408889634f;
constexpr int NTHR = 512;
constexpr int PROBE_K = -1;
constexpr int SMEM_BYTES = 256 * 528;
constexpr int EPI_LD = 264;

constexpr size_t MiB = 1024 * 1024;
constexpr size_t OFF_BAR = 0;
constexpr size_t OFF_ROPE = 16384;
constexpr size_t OFF_RSTD = OFF_ROPE + 262144;
constexpr size_t OFF_WI = OFF_RSTD + 65536;
constexpr size_t OFF_LF = OFF_WI + 524288;
constexpr size_t OFF_CS = OFF_LF + 524288;
constexpr size_t OFF_KMEAN = OFF_CS + 524288;
constexpr size_t OFF_NORM = OFF_KMEAN + 131072;
constexpr size_t OFF_XB = 2 * MiB;
constexpr size_t OFF_WIN = 34 * MiB;
constexpr size_t OFF_WBR = 54 * MiB;
constexpr size_t OFF_WOUT = 57 * MiB;
constexpr size_t OFF_MASK = 59 * MiB;
constexpr size_t OFF_KI = 67 * MiB;
constexpr size_t OFF_QI = 69 * MiB;
constexpr size_t OFF_Q0 = 85 * MiB;
constexpr size_t OFF_VT0 = 181 * MiB;
constexpr size_t OFF_G0 = 229 * MiB;
constexpr size_t WS_NEED = 277 * MiB;
constexpr size_t OFF_MERGED = OFF_Q0;
constexpr size_t OFF_SCR = 117 * MiB;

struct Params {
  const float* x; const float* norm_gain; const float* w_in; const float* fbias;
  const float* w_branch; const float* w_out; const float* final_gain;
  float* out; char* ws;
};

DI unsigned pk2(float a, float b) {
  typedef __bf16 bf2 __attribute__((ext_vector_type(2)));
  typedef float f2 __attribute__((ext_vector_type(2)));
  f2 v = {a, b};
  bf2 r = __builtin_convertvector(v, bf2);
  return __builtin_bit_cast(unsigned, r);
}
DI u16 f2bf(float a) { return (u16)(pk2(a, 0.f) & 0xffffu); }
DI float bf2f(unsigned v) { return __uint_as_float(v << 16); }
DI float wave_sum(float v) {
#pragma unroll
  for (int o = 32; o > 0; o >>= 1) v += __shfl_xor(v, o);
  return v;
}
DI int wave_sum_i(int v) {
#pragma unroll
  for (int o = 32; o > 0; o >>= 1) v += __shfl_xor(v, o);
  return v;
}
DI int wave_sum_dpp(int v) {
  v += __builtin_amdgcn_mov_dpp(v, 0xB1, 0xF, 0xF, true);
  v += __builtin_amdgcn_mov_dpp(v, 0x4E, 0xF, 0xF, true);
  v += __builtin_amdgcn_mov_dpp(v, 0x141, 0xF, 0xF, true);
  v += __builtin_amdgcn_mov_dpp(v, 0x140, 0xF, 0xF, true);
  return __builtin_amdgcn_readlane(v, 0) + __builtin_amdgcn_readlane(v, 16) + __builtin_amdgcn_readlane(v, 32) + __builtin_amdgcn_readlane(v, 48);
}
DI int ltid() { int t = threadIdx.x; asm volatile("" : "+v"(t)); return t; }
DI float fast_exp2(float x) { return __builtin_amdgcn_exp2f(x); }

struct TrDesc { const float* src; int src_ld; int k0; int n0; int mode; u16* dst; int dst_ld; const float* gain; };
DI void tr_load(const TrDesc& d, int tid, float (&v)[8]) {
  const int tx = tid & 63, ty = tid >> 6;
  const int n = d.n0 + tx;
  int c = n;
  if (d.mode == 1) c = (n < N1_VALID) ? n : (n >= N1 ? n - (N1 - N1_VALID) : -1);
#pragma unroll
  for (int i = 0; i < 8; ++i) {
    const int k = d.k0 + ty + 8 * i;
    float x = 0.f;
    if (c >= 0) x = d.src[(size_t)k * d.src_ld + c];
    if (d.gain) x *= d.gain[k];
    v[i] = x;
  }
}
DI void tr_store(const TrDesc& d, int tid, const float (&v)[8], float* lds) {
  {
    const int tx = tid & 63, ty = tid >> 6;
#pragma unroll
    for (int i = 0; i < 8; ++i) lds[(ty + 8 * i) * 65 + tx] = v[i];
  }
  __syncthreads();
  {
    const int kx = (tid & 31) * 2, ny = tid >> 5;
#pragma unroll
    for (int i = 0; i < 4; ++i) {
      const int nn = ny + 16 * i;
      const unsigned pv = pk2(lds[kx * 65 + nn], lds[(kx + 1) * 65 + nn]);
      *(unsigned*)(d.dst + (size_t)(d.n0 + nn) * d.dst_ld + d.k0 + kx) = pv;
    }
  }
  __syncthreads();
}

DI void phase_prep(const Params& p, int layer) {
  extern __shared__ __attribute__((aligned(16))) char smem[];
  float* lds = (float*)smem;
  const int tid = ltid(), wave = tid >> 6, lane = tid & 63;
  const int G = gridDim.x, g = blockIdx.x;
  if (layer == 0) {
    float2* rope = (float2*)(p.ws + OFF_ROPE);
    for (int e = g * NTHR + tid; e < SEQ * 8; e += G * NTHR) {
      const int pos = e >> 3, i = e & 7;
      const float invf = i == 0 ? 1.0f : i == 1 ? 0.1939227432012558f : i == 2 ? 0.03760603070259094f : i == 3 ? 0.007292664609849453f
                       : i == 4 ? 0.0014142135623842478f : i == 5 ? 0.00027424818836152554f : i == 6 ? 5.3182957344688475e-05f : 1.0313385246263351e-05f;
      const float ang = (float)pos * invf;
      const float kf = rintf(ang * 0.6366197723675814f);
      const int kq = (int)kf;
      float rr = fmaf(kf, -1.5703125f, ang);
      rr = fmaf(kf, -4.837512969970703125e-4f, rr);
      rr = fmaf(kf, -7.54978995489188216e-8f, rr);
      const float r2 = rr * rr;
      float ks3 = -1.9515295891e-4f, kc3 = 2.443315711809948e-5f;
      asm volatile("" : "+v"(ks3), "+v"(kc3));
      const float sp = fmaf(rr * r2, fmaf(r2, fmaf(r2, ks3, 8.3321608736e-3f), -1.6666654611e-1f), rr);
      const float cp = fmaf(r2 * r2, fmaf(r2, fmaf(r2, kc3, -1.388731625493765e-3f), 4.166664568298827e-2f), fmaf(r2, -0.5f, 1.0f));
      float sn, cs;
      if ((kq & 3) == 0) { sn = sp; cs = cp; } else if ((kq & 3) == 1) { sn = cp; cs = -sp; } else if ((kq & 3) == 2) { sn = -sp; cs = -cp; } else { sn = -cp; cs = sp; }
      rope[e] = make_float2(cs, sn);
    }
  }
  {
    const float* src = layer == 0 ? p.x : p.out;
    u16* xb = (u16*)(p.ws + OFF_XB);
    float* rstd = (float*)(p.ws + OFF_RSTD);
    for (int row = g * 8 + wave; row < T_TOK; row += G * 8) {
      const float4* s4 = (const float4*)(src + (size_t)row * DM);
      float ss = 0.f;
      float4 v[4];
#pragma unroll
      for (int i = 0; i < 4; ++i) { v[i] = s4[lane + 64 * i]; ss += v[i].x * v[i].x + v[i].y * v[i].y + v[i].z * v[i].z + v[i].w * v[i].w; }
      ss = wave_sum(ss);
#pragma unroll
      for (int i = 0; i < 4; ++i) {
        u32x2 o; o[0] = pk2(v[i].x, v[i].y); o[1] = pk2(v[i].z, v[i].w);
        *(u32x2*)(xb + (size_t)row * DM + (lane + 64 * i) * 4) = o;
      }
      if (lane == 0) rstd[row] = rsqrtf(ss * (1.0f / DM) + 1e-6f);
    }
  }
  {
    const float* w_in = p.w_in + (size_t)layer * DM * D_IN;
    const float* gain = p.norm_gain + (size_t)layer * DM;
    const float* w_br = p.w_branch + (size_t)layer * 3 * WID * DM;
    const float* w_out = p.w_out + (size_t)layer * DM * DM;
    u16* win_t = (u16*)(p.ws + OFF_WIN);
    u16* wbr_t = (u16*)(p.ws + OFF_WBR);
    u16* wout_t = (u16*)(p.ws + OFF_WOUT);
    constexpr int NT_IN = 16 * (NWROWS / 64);
    constexpr int NT_BR = 3 * 8 * 16;
    constexpr int NT_OUT = 16 * 16;
    constexpr int NT_ALL = NT_IN + NT_BR + NT_OUT;
    auto desc = [&](int t) {
      TrDesc d;
      if (t < NT_IN) {
        const int kt = t & 15, nt = t >> 4;
        d.src = w_in; d.src_ld = D_IN; d.k0 = kt * 64; d.n0 = nt * 64; d.mode = 1; d.dst = win_t; d.dst_ld = DM; d.gain = gain;
      } else if (t < NT_IN + NT_BR) {
        const int u = t - NT_IN; const int nb = u / 128, r = u % 128; const int kt = r & 7, nt = r >> 3;
        d.src = w_br + (size_t)nb * WID * DM; d.src_ld = DM; d.k0 = kt * 64; d.n0 = nt * 64; d.mode = 0; d.dst = wbr_t + (size_t)nb * DM * WID; d.dst_ld = WID; d.gain = nullptr;
      } else {
        const int u = t - NT_IN - NT_BR; const int kt = u & 15, nt = u >> 4;
        d.src = w_out; d.src_ld = DM; d.k0 = kt * 64; d.n0 = nt * 64; d.mode = 0; d.dst = wout_t; d.dst_ld = DM; d.gain = nullptr;
      }
      return d;
    };
    float va[8], vb[8];
    int t = g;
    if (t < NT_ALL) { const TrDesc d0 = desc(t); tr_load(d0, tid, va); }
    for (; t < NT_ALL; t += 2 * G) {
      const TrDesc dc = desc(t);
      const bool h1 = (t + G < NT_ALL), h2 = (t + 2 * G < NT_ALL);
      if (h1) { const TrDesc dn = desc(t + G); tr_load(dn, tid, vb); }
      tr_store(dc, tid, va, lds);
      if (h1) {
        if (h2) { const TrDesc dn2 = desc(t + 2 * G); tr_load(dn2, tid, va); }
        const TrDesc dn = desc(t + G);
        tr_store(dn, tid, vb, lds);
      }
    }
  }
}

constexpr int G_BK = 64, G_HALF = 128, G_HT = G_HALF * G_BK;
DI int lds_byte(int r, int c) {
  int st = (r >> 4) * 2 + (c >> 5), rr = r & 15, cc = c & 31, ob = rr * 64 + cc * 2;
  return st * 1024 + (ob ^ (((ob >> 9) & 1) << 5));
}
DI void stage_rc(int b, int& R, int& C) {
  int st = b / 1024, sb = b % 1024, swz = sb ^ (((sb >> 9) & 1) << 5);
  R = (st >> 1) * 16 + swz / 64; C = (st & 1) * 32 + (swz % 64) / 2;
}

template <class Pre, class Epi>
DI void gemm_unit(const u16* __restrict__ A, int lda, const u16* __restrict__ Bt, int ldb, int K, int brow, int bcol, Pre&& pre, Epi&& epi) {
  extern __shared__ __attribute__((aligned(16))) char smem[];
  u16* shm = (u16*)smem;
#define SA(b, h) (shm + ((b) * 2 + (h)) * G_HT)
#define SB(b, h) (shm + (4 + (b) * 2 + (h)) * G_HT)
#define STAGE_(P, BASE, LD, br, kt, _o0, _o1) do { const char* _gp = (const char*)((BASE) + ((size_t)(br) * (LD) + (size_t)(kt) * G_BK)); \
    __builtin_amdgcn_global_load_lds((const unsigned*)(_gp + (size_t)(_o0)), \
        (__attribute__((address_space(3))) unsigned*)((char*)(P) + tidl * 16), 16, 0, 0); \
    __builtin_amdgcn_global_load_lds((const unsigned*)(_gp + (size_t)(_o1)), \
        (__attribute__((address_space(3))) unsigned*)((char*)(P) + tidl * 16 + 8192), 16, 0, 0); } while (0)
#define STAGE(P, BASE, LD, br, kt) STAGE_SEL_##BASE(P, LD, br, kt)
#define STAGE_SEL_A(P, LD, br, kt) STAGE_(P, A, LD, br, kt, offA0, offA1)
#define STAGE_SEL_Bt(P, LD, br, kt) STAGE_(P, Bt, LD, br, kt, offB0, offB1)
#define LDA(dst, b, h) for (int m = 0; m < 4; ++m) for (int k = 0; k < 2; ++k) \
    dst[m][k] = *reinterpret_cast<const bf16x8*>((char*)SA(b, h) + lds_byte(wr * 64 + m * 16 + fr, k * 32 + fq * 8))
#define LDB(dst, b, h) for (int n = 0; n < 2; ++n) for (int k = 0; k < 2; ++k) \
    dst[n][k] = *reinterpret_cast<const bf16x8*>((char*)SB(b, h) + lds_byte(wc * 32 + n * 16 + fr, k * 32 + fq * 8))
#define MMA(ai, bj, At, Bt_) do { __builtin_amdgcn_s_setprio(1); \
    for (int m = 0; m < 4; ++m) for (int n = 0; n < 2; ++n) for (int k = 0; k < 2; ++k) \
      acc[ai][bj][m][n] = __builtin_amdgcn_mfma_f32_16x16x32_bf16(At[m][k], Bt_[n][k], acc[ai][bj][m][n], 0, 0, 0); \
    __builtin_amdgcn_s_setprio(0); } while (0)
#define WAIT_V(n) asm volatile("s_waitcnt vmcnt(" #n ")" ::: "memory")
#define WAIT_L(n) asm volatile("s_waitcnt lgkmcnt(" #n ")" ::: "memory")
#define BAR __builtin_amdgcn_s_barrier()
#define SCHED __builtin_amdgcn_sched_barrier(0)
  int tidl = threadIdx.x; asm volatile("" : "+v"(tidl));
  const int wid = __builtin_amdgcn_readfirstlane(tidl >> 6), lane = tidl & 63, wr = wid >> 2, wc = wid & 3, fr = lane & 15, fq = lane >> 4;
  f32x4 acc[2][2][4][2] = {};
  bf16x8 At[4][2], B0[2][2], B1[2][2];
  const int nt = K / G_BK;
  unsigned offA0, offA1, offB0, offB1;
  { int _r, _c; stage_rc(tidl * 16, _r, _c); offA0 = (unsigned)(_r * lda + _c) * 2u; offB0 = (unsigned)(_r * ldb + _c) * 2u;
    stage_rc(tidl * 16 + 8192, _r, _c); offA1 = (unsigned)(_r * lda + _c) * 2u; offB1 = (unsigned)(_r * ldb + _c) * 2u; }
  STAGE(SB(0, 0), Bt, ldb, bcol, 0); STAGE(SA(0, 0), A, lda, brow, 0);
  STAGE(SB(0, 1), Bt, ldb, bcol + G_HALF, 0); STAGE(SA(0, 1), A, lda, brow + G_HALF, 0);
  if (wr == 1) BAR;
  WAIT_V(4); BAR;
  STAGE(SB(1, 0), Bt, ldb, bcol, 1); STAGE(SA(1, 0), A, lda, brow, 1); STAGE(SB(1, 1), Bt, ldb, bcol + G_HALF, 1);
  WAIT_V(6); BAR;
  for (int t = 0; t < nt - 2; t += 2) {
    LDB(B0, 0, 0); SCHED; LDA(At, 0, 0); STAGE(SA(1, 1), A, lda, brow + G_HALF, t + 1);
    WAIT_L(8); BAR; WAIT_L(0); MMA(0, 0, At, B0); BAR; SCHED;
    LDB(B1, 0, 1); STAGE(SB(0, 0), Bt, ldb, bcol, t + 2);
    BAR; WAIT_L(0); MMA(0, 1, At, B1); BAR;
    LDA(At, 0, 1); STAGE(SA(0, 0), A, lda, brow, t + 2);
    BAR; WAIT_L(0); MMA(1, 0, At, B0); BAR; SCHED;
    STAGE(SB(0, 1), Bt, ldb, bcol + G_HALF, t + 2);
    WAIT_V(6); BAR; MMA(1, 1, At, B1); BAR;
    LDB(B0, 1, 0); SCHED; LDA(At, 1, 0); STAGE(SA(0, 1), A, lda, brow + G_HALF, t + 2);
    WAIT_L(8); BAR; WAIT_L(0); MMA(0, 0, At, B0); BAR; SCHED;
    LDB(B1, 1, 1); STAGE(SB(1, 0), Bt, ldb, bcol, t + 3);
    BAR; WAIT_L(0); MMA(0, 1, At, B1); BAR;
    LDA(At, 1, 1); STAGE(SA(1, 0), A, lda, brow, t + 3);
    BAR; WAIT_L(0); MMA(1, 0, At, B0); BAR; SCHED;
    STAGE(SB(1, 1), Bt, ldb, bcol + G_HALF, t + 3);
    WAIT_V(6); BAR; MMA(1, 1, At, B1); BAR;
  }
  { LDB(B0, 0, 0); LDA(At, 0, 0); STAGE(SA(1, 1), A, lda, brow + G_HALF, nt - 1);
    BAR; WAIT_L(0); MMA(0, 0, At, B0); BAR;
    LDB(B1, 0, 1); BAR; WAIT_L(0); MMA(0, 1, At, B1); BAR;
    LDA(At, 0, 1); WAIT_V(4); BAR; WAIT_L(0); MMA(1, 0, At, B0); MMA(1, 1, At, B1); BAR; }
  { LDB(B0, 1, 0); LDA(At, 1, 0); WAIT_V(2); BAR; WAIT_L(0); MMA(0, 0, At, B0); BAR;
    LDB(B1, 1, 1); WAIT_V(0); BAR; WAIT_L(0); MMA(0, 1, At, B1); BAR;
    LDA(At, 1, 1); BAR; WAIT_L(0); MMA(1, 0, At, B0); MMA(1, 1, At, B1); BAR; }
  if (wr == 0) BAR;
#define PRE(ai, m) pre(ai, m, brow + ai * 128 + wr * 64 + m * 16 + fq * 4, bcol + wc * 32 + fr)
#define EPI1(ai, bj, m, n) { int _r0 = brow + ai * 128 + wr * 64 + m * 16 + fq * 4, _c0 = bcol + bj * 128 + wc * 32 + n * 16 + fr; asm volatile("" : "+v"(_r0), "+v"(_c0)); epi(ai, bj, m, n, acc[ai][bj][m][n], _r0, _c0, pcur); }
#define EPIG(ai, m, ain, mn) { auto pnext = PRE(ain, mn); EPI1(ai, 0, m, 0) EPI1(ai, 0, m, 1) EPI1(ai, 1, m, 0) EPI1(ai, 1, m, 1) pcur = pnext; SCHED; }
  auto pcur = PRE(0, 0);
  EPIG(0, 0, 0, 1) EPIG(0, 1, 0, 2) EPIG(0, 2, 0, 3) EPIG(0, 3, 1, 0) EPIG(1, 0, 1, 1) EPIG(1, 1, 1, 2) EPIG(1, 2, 1, 3) EPIG(1, 3, 1, 3)
#undef PRE
#undef EPI1
#undef EPIG
#undef SA
#undef SB
#undef STAGE
#undef STAGE_
#undef STAGE_SEL_A
#undef STAGE_SEL_Bt
#undef LDA
#undef LDB
#undef MMA
}

DI void tile_copy_out(u16* __restrict__ dst, size_t ld) {
  extern __shared__ __attribute__((aligned(16))) char smem[];
  const u16* lds16 = (const u16*)smem;
  const int tid = ltid();
  __syncthreads();
#pragma unroll 4
  for (int it = 0; it < 16; ++it) {
    const int id = it * NTHR + tid; const int row = id >> 5, cc = id & 31;
    const u32x4 v = *(const u32x4*)(lds16 + row * EPI_LD + cc * 8);
    *(u32x4*)(dst + (size_t)row * ld + cc * 8) = v;
  }
  __syncthreads();
}

DI void phase_proj(const Params& p, int layer) {
  const u16* xb = (const u16*)(p.ws + OFF_XB);
  const u16* win_t = (const u16*)(p.ws + OFF_WIN);
  const float* rstd = (const float*)(p.ws + OFF_RSTD);
  const float2* rope = (const float2*)(p.ws + OFF_ROPE);
  const float* fb = p.fbias + layer * 8;
  extern __shared__ __attribute__((aligned(16))) char smem[];
  u16* lds16 = (u16*)smem;
  const int tid_ = ltid(), lane = tid_ & 63, wid = tid_ >> 6, wc = wid & 3, fr = lane & 15;
  constexpr int NU = 64 * 27;
  for (int u = blockIdx.x; u < NU; u += gridDim.x) {
    const int pn = u / 64, pm = u % 64;
    const int brow = pm * 256, bcol = pn * 256;
    char* ws = p.ws;
    struct PreP { float rs[4]; float2 cs[4]; };
    const bool tile_rope = (pn >= 24 && pn < 27) || (pn < 24 && ((pn >> 1) & 3) < 2 && (pn >> 3) < 2);
    gemm_unit(xb, DM, win_t, DM, DM, brow, bcol,
      [&](int ai, int m, int row0, int col0) {
        PreP q;
        asm volatile("" : "+v"(row0));
#pragma unroll
        for (int j = 0; j < 4; ++j) q.rs[j] = rstd[row0 + j];
        if (tile_rope) {
#pragma unroll
          for (int j = 0; j < 4; ++j) q.cs[j] = rope[((row0 + j) & (SEQ - 1)) * 8 + (fr & 7)];
        } else {
#pragma unroll
          for (int j = 0; j < 4; ++j) q.cs[j] = make_float2(1.f, 0.f);
        }
        return q;
      },
      [&](int ai, int bj, int m, int n, f32x4 a, int row0, int col, const PreP& q) {
        float v[4];
#pragma unroll
        for (int j = 0; j < 4; ++j) v[j] = a[j] * q.rs[j];
        if (pn < 26) {
          const int sec = pn >> 1;
          const int br = sec >> 2, kind = (pn < 24) ? (sec & 3) : 0;
          const int c = col - sec * 512;
          const bool rope_on = (pn >= 24) || ((kind == 0 || kind == 1) && br < 2);
          if (rope_on && n == 0 && (wc & 1) == 0) {
            const float sg = (fr < 8) ? -1.f : 1.f;
#pragma unroll
            for (int j = 0; j < 4; ++j) {
              const float pr = __shfl_xor(v[j], 8);
              v[j] = v[j] * q.cs[j].x + sg * pr * q.cs[j].y;
            }
          }
          const int lr = row0 - brow, lc = col - bcol;
          if (pn < 24 && kind == 2) {
            u32x2 o; o[0] = pk2(v[0], v[1]); o[1] = pk2(v[2], v[3]);
            *(u32x2*)(lds16 + lc * EPI_LD + lr) = o;
          } else {
            if (pn < 24 && kind == 0) {
#pragma unroll
              for (int j = 0; j < 4; ++j) v[j] *= QSCALE;
            } else if (pn < 24 && kind == 3) {
#pragma unroll
              for (int j = 0; j < 4; ++j) v[j] = v[j] * __builtin_amdgcn_rcpf(1.f + __expf(-v[j]));
            }
#pragma unroll
            for (int j = 0; j < 4; ++j) lds16[(lr + j) * EPI_LD + lc] = f2bf(v[j]);
          }
        } else {
          const int c = col - 26 * 256;
          if (c < 64) {
            if (c < 16) {
              const float sg = (fr < 8) ? -1.f : 1.f;
#pragma unroll
              for (int j = 0; j < 4; ++j) {
                const float pr = __shfl_xor(v[j], 8);
                v[j] = v[j] * q.cs[j].x + sg * pr * q.cs[j].y;
              }
            }
            u16* ki = (u16*)(ws + OFF_KI);
#pragma unroll
            for (int j = 0; j < 4; ++j) ki[(size_t)(row0 + j) * 64 + c] = f2bf(v[j]);
          } else if (c < 72) {
            float* wi = (float*)(ws + OFF_WI);
#pragma unroll
            for (int j = 0; j < 4; ++j) wi[(size_t)(row0 + j) * 8 + (c - 64)] = v[j] * 0.04419417382415922f;
          } else if (c < 80) {
            float* lf = (float*)(ws + OFF_LF);
            const float bias = fb[c - 72];
#pragma unroll
            for (int j = 0; j < 4; ++j) { const float z = v[j] + bias; lf[(size_t)(row0 + j) * 8 + (c - 72)] = fminf(z, 0.f) - log1pf(__expf(-fabsf(z))); }
          }
        }
      });
    if (pn < 26) {
      const int sec = pn >> 1, br = sec >> 2, kind = (pn < 24) ? (sec & 3) : 0, cb = (pn & 1) * 256;
      if (pn >= 24) tile_copy_out((u16*)(ws + OFF_QI) + (size_t)brow * 512 + cb, 512);
      else if (kind == 0) tile_copy_out((u16*)(ws + OFF_Q0 + (size_t)br * 32 * MiB) + (size_t)brow * 512 + cb, 512);
      else if (kind == 1) tile_copy_out((u16*)(ws + OFF_Q0 + (size_t)br * 32 * MiB + 16 * MiB) + (size_t)brow * 512 + cb, 512);
      else if (kind == 2) tile_copy_out((u16*)(ws + OFF_VT0 + (size_t)br * 16 * MiB) + ((size_t)(brow >> 12) * 512 + cb) * SEQ + (brow & (SEQ - 1)), SEQ);
      else tile_copy_out((u16*)(ws + OFF_G0 + (size_t)br * 16 * MiB) + (size_t)brow * 512 + cb, 512);
    } else __syncthreads();
  }
}

DI unsigned umap(float f) { unsigned u = __float_as_uint(f); return (u & 0x80000000u) ? ~u : (u | 0x80000000u); }

struct SelIn { bf16x8 aq[2][4]; float wv[2][16]; };
DI void select_load(const Params& p, int b, int t0, SelIn& in) {
  const int tid = ltid(), lane = tid & 63, r = lane & 31, half = lane >> 5;
  const u16* qi = (const u16*)(p.ws + OFF_QI);
  const float* wi = (const float*)(p.ws + OFF_WI);
  const int i_ = (r & 3) | ((r >> 3) << 2), hh = (r >> 2) & 1;
#pragma unroll
  for (int be = 0; be < 2; ++be) {
    const int qloc = 4 * be + 2 * hh + (i_ >> 3), head = i_ & 7;
    const u16* src = qi + (size_t)(b * SEQ + t0 + qloc) * 512 + head * 64 + 8 * half;
#pragma unroll
    for (int ks = 0; ks < 4; ++ks) in.aq[be][ks] = *(const bf16x8*)(src + 16 * ks);
  }
#pragma unroll
  for (int be = 0; be < 2; ++be)
#pragma unroll
    for (int e = 0; e < 2; ++e) {
      const float4* w4 = (const float4*)(wi + (size_t)(b * SEQ + t0 + 4 * be + 2 * half + e) * 8);
      const float4 a = w4[0], c = w4[1];
      in.wv[be][8 * e + 0] = a.x; in.wv[be][8 * e + 1] = a.y; in.wv[be][8 * e + 2] = a.z; in.wv[be][8 * e + 3] = a.w;
      in.wv[be][8 * e + 4] = c.x; in.wv[be][8 * e + 5] = c.y; in.wv[be][8 * e + 6] = c.z; in.wv[be][8 * e + 7] = c.w;
    }
}
DI void select_item(const Params& p, int b, int t0, SelIn& in, bool has_next, int nb, int nt0, unsigned long long& acc1, unsigned long long& acc2) {
  const unsigned long long tq0 = (PROBE_K >= 20) ? __builtin_amdgcn_s_memrealtime() : 0ull;
  extern __shared__ __attribute__((aligned(16))) char smem[];
  unsigned* sc = (unsigned*)smem;
  __shared__ __attribute__((aligned(16))) unsigned clist[8][64];
  const int tid = ltid(), wave = tid >> 6, lane = tid & 63, r = lane & 31, half = lane >> 5;
  const u16* ki = (const u16*)(p.ws + OFF_KI);
  const int nkt = t0 / 32 + 1;
  if (t0 + 7 < 256) {
    if (has_next) select_load(p, nb, nt0, in);
    const int t = t0 + wave;
    const int lo = 64 * lane;
    const unsigned long long w = (t >= lo + 63) ? ~0ull : (t < lo ? 0ull : ((1ull << (t - lo + 1)) - 1ull));
    ((unsigned long long*)(p.ws + OFF_MASK) + (size_t)(b * SEQ + t) * 64)[lane] = w;
    return;
  }
  {
    auto& aq = in.aq; auto& wv = in.wv;
    for (int kt0 = wave; kt0 < nkt; kt0 += 32) {
      bf16x8 bk[4][4];
#pragma unroll
      for (int u = 0; u < 4; ++u) {
        const int kt = kt0 + 8 * u;
        if (kt < nkt) {
          const u16* ksrc = ki + (size_t)(b * SEQ + 32 * kt + r) * 64 + 8 * half;
#pragma unroll
          for (int ks = 0; ks < 4; ++ks) bk[u][ks] = *(const bf16x8*)(ksrc + 16 * ks);
        }
      }
#pragma unroll
      for (int u = 0; u < 4; ++u) {
        const int kt = kt0 + 8 * u;
        if (kt < nkt) {
          const int key = 32 * kt + r;
#pragma unroll
          for (int be = 0; be < 2; ++be) {
            f32x16 c;
#pragma unroll
            for (int i = 0; i < 16; ++i) c[i] = 0.f;
#pragma unroll
            for (int ks = 0; ks < 4; ++ks) c = __builtin_amdgcn_mfma_f32_32x32x16_bf16(aq[be][ks], bk[u][ks], c, 0, 0, 0);
#pragma unroll
            for (int e = 0; e < 2; ++e) {
              float sv = 0.f;
#pragma unroll
              for (int i = 0; i < 8; ++i) sv = fmaf(wv[be][8 * e + i], fmaxf(c[8 * e + i], 0.f), sv);
              if (sv == 0.f) sv = 0.f;
              const int q = 4 * be + 2 * half + e;
              sc[q * 4128 + key] = (key <= t0 + q) ? umap(sv) : 0u;
            }
          }
        }
      }
    }
  }
  if (has_next) select_load(p, nb, nt0, in);
  __syncthreads();
  const unsigned long long tq1 = (PROBE_K >= 20) ? __builtin_amdgcn_s_memrealtime() : 0ull;
  {
    const int t = t0 + wave;
    const int L = t + 1;
    const int nvalid = 32 * nkt;
    const int nreg = (nvalid + 63) >> 6;
    unsigned v[64];
#pragma unroll
    for (int j = 0; j < 64; ++j) v[j] = 0u;
    const int ngrp = (nreg + 15) >> 4;
#pragma unroll
    for (int gq = 0; gq < 4; ++gq) {
      if (gq < ngrp) {
#pragma unroll
        for (int jj = 0; jj < 16; ++jj) { const int j = gq * 16 + jj; const int key = 64 * j + lane; if (key < nvalid) v[j] = sc[wave * 4128 + key]; }
      }
    }
    unsigned thr = 1u;
    int need_eq = -1;
    if (L > 256) {
      unsigned P = 0u; bool done = false;
      int n_ge = 64 * 64, c_above = 0;
      int bit = 31;
      for (; bit >= 0; --bit) {
        const unsigned cand = P | (1u << bit);
        int cl = 0;
#pragma unroll
        for (int gq = 0; gq < 4; ++gq) {
          if (gq < ngrp) {
#pragma unroll
            for (int jj = 0; jj < 16; ++jj) cl += (v[gq * 16 + jj] >= cand) ? 1 : 0;
          }
        }
        const int c = wave_sum_dpp(cl);
        if (c >= 256) { P = cand; n_ge = c; } else c_above = c;
        if (c == 256) { done = true; break; }
        if (n_ge - c_above <= 64) { --bit; break; }
      }
      if (!done && bit >= 0) {
        unsigned* cl = clist[wave];
        int base = 0;
        const unsigned sh = (unsigned)(bit + 1);
#pragma unroll
        for (int gq = 0; gq < 4; ++gq) {
          if (gq < ngrp) {
#pragma unroll
            for (int jj = 0; jj < 16; ++jj) {
              const unsigned x = v[gq * 16 + jj];
              const bool und = ((x ^ P) >> sh) == 0u;
              const unsigned long long m = __ballot(und);
              if (und) cl[base + __popcll(m & ((1ull << lane) - 1ull))] = x;
              base += __popcll(m);
            }
          }
        }
        const unsigned vc = (lane < base) ? cl[lane] : 0u;
        for (; bit >= 0; --bit) {
          const unsigned cand = P | (1u << bit);
          const int c = c_above + __popcll(__ballot(vc >= cand));
          if (c >= 256) P = cand;
          if (c == 256) { done = true; break; }
        }
      }
      thr = P;
      if (!done) {
        int cge = 0, cgt = 0;
#pragma unroll
        for (int j = 0; j < 64; ++j) { cge += __popcll(__ballot(v[j] >= P)); cgt += __popcll(__ballot(v[j] > P)); }
        if (cge > 256) need_eq = 256 - cgt;
      }
    }
    unsigned long long mine = 0ull;
    if (need_eq < 0) {
#pragma unroll
      for (int gq = 0; gq < 4; ++gq) {
        if (gq < ngrp) {
#pragma unroll
          for (int jj = 0; jj < 16; ++jj) { const int j = gq * 16 + jj; const unsigned long long bm = __ballot(v[j] >= thr); if (lane == j) mine = bm; }
        }
      }
    } else {
      int eq_seen = 0;
#pragma unroll
      for (int j = 0; j < 64; ++j) {
        const bool eq = v[j] == thr;
        const unsigned long long eb = __ballot(eq);
        const int rank = eq_seen + __popcll(eb & ((1ull << lane) - 1ull));
        const bool sel = (v[j] > thr) || (eq && rank < need_eq);
        eq_seen += __popcll(eb);
        const unsigned long long bm = __ballot(sel);
        if (lane == j) mine = bm;
      }
    }
    unsigned long long* mrow = (unsigned long long*)(p.ws + OFF_MASK) + (size_t)(b * SEQ + t) * 64;
    mrow[lane] = mine;
  }
  __syncthreads();
  if (PROBE_K >= 20) { const unsigned long long tq2 = __builtin_amdgcn_s_memrealtime(); acc1 += tq1 - tq0; acc2 += tq2 - tq1; }
}

DI void phase_select(const Params& p, int layer) {
  const int g = blockIdx.x, G = gridDim.x;
  const int tid = ltid(), wave = tid >> 6, lane = tid & 63;
  __shared__ __attribute__((aligned(16))) float red[8][64];
  for (int it = g * 8 + wave; it < NBATCH * NH; it += G * 8) {
    const int b = it >> 3, h = it & 7;
    const float* lf = (const float*)(p.ws + OFF_LF) + (size_t)b * SEQ * 8 + h;
    float* cs = (float*)(p.ws + OFF_CS) + (size_t)it * SEQ;
    float carry = 0.f;
#pragma unroll 8
    for (int c = 0; c < 64; ++c) {
      float v = lf[(size_t)(64 * c + lane) * 8];
      v += __int_as_float(__builtin_amdgcn_update_dpp(0, __float_as_int(v), 0x111, 0xF, 0xF, false));
      v += __int_as_float(__builtin_amdgcn_update_dpp(0, __float_as_int(v), 0x112, 0xF, 0xF, false));
      v += __int_as_float(__builtin_amdgcn_update_dpp(0, __float_as_int(v), 0x114, 0xF, 0xF, false));
      v += __int_as_float(__builtin_amdgcn_update_dpp(0, __float_as_int(v), 0x118, 0xF, 0xF, false));
      const float t0 = __int_as_float(__builtin_amdgcn_readlane(__float_as_int(v), 15));
      const float t1 = __int_as_float(__builtin_amdgcn_readlane(__float_as_int(v), 31));
      const float t2 = __int_as_float(__builtin_amdgcn_readlane(__float_as_int(v), 47));
      const float t3 = __int_as_float(__builtin_amdgcn_readlane(__float_as_int(v), 63));
      const float add = carry + (lane >= 48 ? (t0 + t1) + t2 : lane >= 32 ? t0 + t1 : lane >= 16 ? t0 : 0.f);
      cs[64 * c + lane] = (v + add) * LOG2E;
      carry += ((t0 + t1) + t2) + t3;
    }
  }
  for (int task = g * 8 + wave; task < 2 * NBATCH * NH * 64; task += G * 8) {
    const int which = task >> 11, rem = task & 2047, bh = rem >> 6, g64 = rem & 63;
    const u16* base = (const u16*)(p.ws + OFF_Q0 + (size_t)2 * 32 * MiB + (which ? 16 * MiB : 0));
    const u16* row = base + ((size_t)(bh >> 3) * SEQ + g64 * 64 + lane) * 512 + (bh & 7) * 64;
    float n2 = 0.f;
#pragma unroll
    for (int c8 = 0; c8 < 8; ++c8) {
      const u32x4 w = *(const u32x4*)(row + 8 * c8);
#pragma unroll
      for (int e = 0; e < 4; ++e) { const float lo = bf2f(w[e] & 0xffffu), hi = bf2f(w[e] >> 16); n2 = fmaf(lo, lo, n2); n2 = fmaf(hi, hi, n2); }
    }
#pragma unroll
    for (int o = 32; o > 0; o >>= 1) n2 = fmaxf(n2, __shfl_xor(n2, o));
    if (lane == 0) ((float*)(p.ws + OFF_NORM))[task] = n2;
  }
  for (int pr = g; pr < 256; pr += G) {
    const int item = pr * 2 + (wave >> 2);
    const int b = item >> 7, h = (item >> 4) & 7, n = item & 15;
    const u16* k = (const u16*)(p.ws + OFF_Q0 + 16 * MiB) + (size_t)(b * SEQ + n * 256 + (wave & 3) * 64) * 512 + h * 64 + lane;
    float s = 0.f;
    for (int i = 0; i < 64; ++i) s += bf2f(k[(size_t)i * 512]);
    red[wave][lane] = s;
    __syncthreads();
    if ((wave & 3) == 0) {
      const float tot = red[wave][lane] + red[wave + 1][lane] + red[wave + 2][lane] + red[wave + 3][lane];
      ((float*)(p.ws + OFF_KMEAN))[(size_t)item * 64 + lane] = tot * (1.f / 256.f);
    }
    __syncthreads();
  }
  unsigned long long acc1 = 0ull, acc2 = 0ull;
  {
    unsigned* ctr = (unsigned*)(p.ws + OFF_BAR) + 16 + layer;
    __shared__ int sel_next;
    if (tid == 0) sel_next = (int)atomicAdd(ctr, 1u);
    __syncthreads();
    int idx = sel_next;
    __syncthreads();
    SelIn in;
    bool have = idx < 2048;
    if (have) select_load(p, idx & 3, (511 - (idx >> 2)) * 8, in);
    while (have) {
      if (tid == 0) sel_next = (int)atomicAdd(ctr, 1u);
      __syncthreads();
      const int nidx = sel_next;
      const bool has_next = nidx < 2048;
      select_item(p, idx & 3, (511 - (idx >> 2)) * 8, in, has_next, nidx & 3, (511 - (nidx >> 2)) * 8, acc1, acc2);
      have = has_next; idx = nidx;
    }
  }
  if (PROBE_K == 20 || PROBE_K == 21) {
    const unsigned long long w = (PROBE_K == 20) ? acc1 : acc2;
    const unsigned long long t1 = __builtin_amdgcn_s_memrealtime();
    while (__builtin_amdgcn_s_memrealtime() - t1 < w) __builtin_amdgcn_s_sleep(8);
  }
}

DI int perm23(int r) { return (r & ~12) | ((r & 4) << 1) | ((r & 8) >> 1); }

DI void attn_item(const Params& p, int br, int b, int h, int qb) {
  extern __shared__ __attribute__((aligned(16))) char smem[];
  u16* Ks = (u16*)smem;
  u16* Vs = (u16*)(smem + 4 * 64 * 144);
  float* cks = (float*)(smem + 8 * 64 * 144);
  float* kmS = (float*)(smem + 8 * 64 * 144 + 1024);
  const int tid = ltid(), wave = tid >> 6, lane = tid & 63, r = lane & 31, half = lane >> 5;
  const u16* Qp = (const u16*)(p.ws + OFF_Q0 + (size_t)br * 32 * MiB);
  const u16* Kp = (const u16*)(p.ws + OFF_Q0 + (size_t)br * 32 * MiB + 16 * MiB);
  const u16* VTp = (const u16*)(p.ws + OFF_VT0 + (size_t)br * 16 * MiB) + (size_t)(b * 8 + h) * 64 * SEQ;
  u16* Gp = (u16*)(p.ws + OFF_G0 + (size_t)br * 16 * MiB);
  const float* csrow = (const float*)(p.ws + OFF_CS) + (size_t)(b * 8 + h) * SEQ;
  const unsigned* maskp = (const unsigned*)(p.ws + OFF_MASK);
  const int qpos = qb * 256 + wave * 32 + r;
  const size_t qtok = (size_t)b * SEQ + qpos;

  bf16x8 qf[4];
#pragma unroll
  for (int ks = 0; ks < 4; ++ks) qf[ks] = *(const bf16x8*)(Qp + qtok * 512 + h * 64 + 16 * ks + 8 * half);

  unsigned selmask = 0u;
  if (br == 0 && qb > 0) {
    if (qb <= 3) selmask = (1u << qb) - 1u;
    else {
      const float* kmg = (const float*)(p.ws + OFF_KMEAN) + (size_t)(b * 8 + h) * 16 * 64;
      __syncthreads();
      kmS[tid] = kmg[tid]; kmS[tid + 512] = kmg[tid + 512];
      __syncthreads();
      const float* km = kmS;
      float qv[64];
      const u16* qrow = Qp + qtok * 512 + h * 64;
#pragma unroll
      for (int c8 = 0; c8 < 8; ++c8) {
        const u32x4 w = *(const u32x4*)(qrow + 8 * c8);
#pragma unroll
        for (int e = 0; e < 4; ++e) { qv[8 * c8 + 2 * e] = bf2f(w[e] & 0xffffu); qv[8 * c8 + 2 * e + 1] = bf2f(w[e] >> 16); }
      }
      float v0 = -INFINITY, v1 = -INFINITY, v2 = -INFINITY; int i0 = 0, i1 = 0, i2 = 0;
      for (int n = 0; n < qb; ++n) {
        float gsc = 0.f;
#pragma unroll
        for (int d4 = 0; d4 < 16; ++d4) {
          const float4 kk4 = *(const float4*)(km + n * 64 + 4 * d4);
          gsc = fmaf(qv[4 * d4], kk4.x, gsc); gsc = fmaf(qv[4 * d4 + 1], kk4.y, gsc); gsc = fmaf(qv[4 * d4 + 2], kk4.z, gsc); gsc = fmaf(qv[4 * d4 + 3], kk4.w, gsc);
        }
        if (gsc > v0) { v2 = v1; i2 = i1; v1 = v0; i1 = i0; v0 = gsc; i0 = n; }
        else if (gsc > v1) { v2 = v1; i2 = i1; v1 = gsc; i1 = n; }
        else if (gsc > v2) { v2 = gsc; i2 = n; }
      }
      selmask = (1u << i0) | (1u << i1) | (1u << i2);
    }
  }

  const int nkt = (qb + 1) * 4;
  const int my_last = qb * 4 + (wave >> 1);
  const int lrow = tid >> 3, lchunk = tid & 7;
  const u16* ksrc = Kp + ((size_t)b * SEQ + lrow) * 512 + h * 64 + lchunk * 8;
  const u16* vsrc = VTp + (size_t)lrow * SEQ + lchunk * 8;
  const int lds_off = lrow * 72 + lchunk * 8;
  const int kr = perm23(r);
  const int kfo = kr * 72 + 8 * half;
  const int vfo = r * 72 + 8 * half;

  int kp_start = 0;
  if (br == 2 && qb > 0) {
    const float* nq = (const float*)(p.ws + OFF_NORM) + (size_t)(b * 8 + h) * 64;
    const float* nk = nq + 2048;
    const float q2 = fmaxf(fmaxf(nq[4 * qb], nq[4 * qb + 1]), fmaxf(nq[4 * qb + 2], nq[4 * qb + 3]));
    const float ks2 = fmaxf(fmaxf(nk[4 * qb], nk[4 * qb + 1]), fmaxf(nk[4 * qb + 2], nk[4 * qb + 3]));
    const int npast = 2 * qb;
    bool ok = false;
    if (lane < npast) {
      const int kpl = 2 * lane;
      const float k2 = fmaxf(nk[kpl], nk[kpl + 1]);
      const float bound = sqrtf(q2) * (sqrtf(k2) + sqrtf(ks2)) * 1.01f;
      const float dmin = csrow[64 * (kpl + 2) - 1] - csrow[256 * qb];
      ok = (bound - dmin < -40.f);
    }
    const unsigned long long okm = __ballot(ok);
    const int first_not = __builtin_ctzll(~okm);
    kp_start = 2 * first_not;
  }
  {
    const int s0 = kp_start & 2;
    const u32x4 k0 = *(const u32x4*)(ksrc + (size_t)kp_start * 64 * 512);
    const u32x4 v0 = *(const u32x4*)(vsrc + kp_start * 64);
    const u32x4 k1 = *(const u32x4*)(ksrc + (size_t)(kp_start + 1) * 64 * 512);
    const u32x4 v1 = *(const u32x4*)(vsrc + (kp_start + 1) * 64);
    float c0 = 0.f;
    if (br == 2 && tid < 128) c0 = csrow[kp_start * 64 + tid];
    __syncthreads();
    *(u32x4*)(Ks + s0 * 64 * 72 + lds_off) = k0;
    *(u32x4*)(Vs + s0 * 64 * 72 + lds_off) = v0;
    *(u32x4*)(Ks + (s0 + 1) * 64 * 72 + lds_off) = k1;
    *(u32x4*)(Vs + (s0 + 1) * 64 * 72 + lds_off) = v1;
    if (br == 2 && tid < 128) cks[s0 * 64 + tid] = c0;
    __syncthreads();
  }

  f32x16 o0, o1;
#pragma unroll
  for (int i = 0; i < 16; ++i) { o0[i] = 0.f; o1[i] = 0.f; }
  float mrun = -1e30f, lrun = 0.f;

  auto tile2 = [&](int kp, int sb, const u32x4& mw) {
    f32x16 s[4];
#pragma unroll
    for (int t = 0; t < 4; ++t)
#pragma unroll
      for (int i = 0; i < 16; ++i) s[t][i] = 0.f;
#pragma unroll
    for (int t = 0; t < 2; ++t) {
      const u16* Kb = Ks + (sb + t) * 64 * 72 + kfo;
      bf16x8 kf[8];
#pragma unroll
      for (int ks = 0; ks < 4; ++ks) { kf[2 * ks] = *(const bf16x8*)(Kb + 16 * ks); kf[2 * ks + 1] = *(const bf16x8*)(Kb + 32 * 72 + 16 * ks); }
      __builtin_amdgcn_sched_barrier(0);
#pragma unroll
      for (int ks = 0; ks < 4; ++ks) {
        s[2 * t] = __builtin_amdgcn_mfma_f32_32x32x16_bf16(kf[2 * ks], qf[ks], s[2 * t], 0, 0, 0);
        s[2 * t + 1] = __builtin_amdgcn_mfma_f32_32x32x16_bf16(kf[2 * ks + 1], qf[ks], s[2 * t + 1], 0, 0, 0);
      }
      __builtin_amdgcn_sched_barrier(0);
    }
    if (br == 2) {
      const float* cb = cks + sb * 64;
#pragma unroll
      for (int t = 0; t < 4; ++t)
#pragma unroll
        for (int i = 0; i < 16; ++i) s[t][i] -= cb[32 * t + (i & 7) + 8 * half + 16 * (i >> 3)];
    }
    bool lane_on = true;
    const bool diag = (kp >= qb * 4);
    if (br != 1 && diag) {
#pragma unroll
      for (int t = 0; t < 4; ++t) {
        const int nv = qpos - 64 * kp - 32 * t + 1;
        unsigned w = nv >= 32 ? 0xffffffffu : (nv <= 0 ? 0u : ((1u << nv) - 1u));
        w >>= (8 * half);
#pragma unroll
        for (int i = 0; i < 16; ++i) s[t][i] = ((w >> ((i & 7) + 16 * (i >> 3))) & 1u) ? s[t][i] : -INFINITY;
      }
    } else if (br == 0) {
      lane_on = (selmask >> (kp >> 2)) & 1u;
    }
    float tmax = -INFINITY;
#pragma unroll
    for (int i = 0; i < 16; ++i) tmax = fmaxf(fmaxf(tmax, fmaxf(s[0][i], s[1][i])), fmaxf(s[2][i], s[3][i]));
    tmax = fmaxf(tmax, __shfl_xor(tmax, 32));
    if (!lane_on) tmax = -INFINITY;
    const float mnew = fmaxf(mrun, tmax);
    const float alpha = fast_exp2(mrun - mnew);
    mrun = mnew;
    const float sub = lane_on ? mnew : INFINITY;
#pragma unroll
    for (int t = 0; t < 4; ++t)
#pragma unroll
      for (int i = 0; i < 16; ++i) s[t][i] = fast_exp2(s[t][i] - sub);
    if (br == 1) {
#pragma unroll
      for (int t = 0; t < 4; ++t) {
        const unsigned w = mw[t] >> (8 * half);
#pragma unroll
        for (int i = 0; i < 16; ++i) s[t][i] = __uint_as_float(__float_as_uint(s[t][i]) & (unsigned)(-(int)((w >> ((i & 7) + 16 * (i >> 3))) & 1u)));
      }
    }
    float psum = 0.f;
#pragma unroll
    for (int i = 0; i < 16; ++i) psum += (s[0][i] + s[1][i]) + (s[2][i] + s[3][i]);
    lrun = lrun * alpha + psum;
    if (__ballot(alpha != 1.f) != 0ull) {
#pragma unroll
      for (int i = 0; i < 16; ++i) { o0[i] *= alpha; o1[i] *= alpha; }
    }
#pragma unroll
    for (int t = 0; t < 2; ++t) {
      const u16* Vb = Vs + (sb + t) * 64 * 72 + vfo;
      bf16x8 vf[8];
#pragma unroll
      for (int kk = 0; kk < 4; ++kk) { vf[2 * kk] = *(const bf16x8*)(Vb + 16 * kk); vf[2 * kk + 1] = *(const bf16x8*)(Vb + 32 * 72 + 16 * kk); }
      bf16x8 pfr[4];
#pragma unroll
      for (int kk = 0; kk < 4; ++kk) {
        const f32x16& sv = s[2 * t + (kk >> 1)];
        const int e = 8 * (kk & 1);
        u32x4 pw;
        pw[0] = pk2(sv[e + 0], sv[e + 1]); pw[1] = pk2(sv[e + 2], sv[e + 3]); pw[2] = pk2(sv[e + 4], sv[e + 5]); pw[3] = pk2(sv[e + 6], sv[e + 7]);
        pfr[kk] = __builtin_bit_cast(bf16x8, pw);
      }
      __builtin_amdgcn_sched_barrier(0);
#pragma unroll
      for (int kk = 0; kk < 4; ++kk) {
        o0 = __builtin_amdgcn_mfma_f32_32x32x16_bf16(vf[2 * kk], pfr[kk], o0, 0, 0, 0);
        o1 = __builtin_amdgcn_mfma_f32_32x32x16_bf16(vf[2 * kk + 1], pfr[kk], o1, 0, 0, 0);
      }
      __builtin_amdgcn_sched_barrier(0);
    }
  };

  u32x4 mw4; mw4[0] = mw4[1] = mw4[2] = mw4[3] = 0u;
  if (br == 1) mw4 = *(const u32x4*)(maskp + qtok * 128);
  for (int kp = kp_start; kp < nkt; kp += 2) {
    const int sb = kp & 2;
    const bool more = (kp + 2 < nkt);
    u32x4 kra, krb, vra, vrb, mwn = mw4; float creg = 0.f;
    if (more) {
      kra = *(const u32x4*)(ksrc + (size_t)(kp + 2) * 64 * 512);
      krb = *(const u32x4*)(ksrc + (size_t)(kp + 3) * 64 * 512);
      vra = *(const u32x4*)(vsrc + (kp + 2) * 64);
      vrb = *(const u32x4*)(vsrc + (kp + 3) * 64);
      if (br == 2 && tid < 128) creg = csrow[(kp + 2) * 64 + tid];
      if (br == 1) mwn = *(const u32x4*)(maskp + qtok * 128 + 2 * (kp + 2));
    }
    if (kp <= my_last) tile2(kp, sb, mw4);
    if (more) {
      const int nb2 = sb ^ 2;
      *(u32x4*)(Ks + nb2 * 64 * 72 + lds_off) = kra;
      *(u32x4*)(Ks + (nb2 + 1) * 64 * 72 + lds_off) = krb;
      *(u32x4*)(Vs + nb2 * 64 * 72 + lds_off) = vra;
      *(u32x4*)(Vs + (nb2 + 1) * 64 * 72 + lds_off) = vrb;
      if (br == 2 && tid < 128) cks[nb2 * 64 + tid] = creg;
    }
    mw4 = mwn;
    __syncthreads();
  }

  const float ltot = lrun + __shfl_xor(lrun, 32);
  const float inv = 1.f / ltot;
  u16* grow = Gp + qtok * 512 + h * 64;
#pragma unroll
  for (int db = 0; db < 2; ++db)
#pragma unroll
    for (int g4 = 0; g4 < 4; ++g4) {
      const int d0 = 32 * db + 8 * g4 + 4 * half;
      const u32x2 gw = *(const u32x2*)(grow + d0);
      float a[4];
#pragma unroll
      for (int e = 0; e < 4; ++e) a[e] = (db == 0 ? o0[4 * g4 + e] : o1[4 * g4 + e]) * inv;
      u32x2 ow;
      ow[0] = pk2(a[0] * bf2f(gw[0] & 0xffffu), a[1] * bf2f(gw[0] >> 16));
      ow[1] = pk2(a[2] * bf2f(gw[1] & 0xffffu), a[3] * bf2f(gw[1] >> 16));
      *(u32x2*)(grow + d0) = ow;
    }
}

DI void phase_attn(const Params& p, int layer) {
  constexpr int NI = 3 * NBATCH * NH * 16;
  unsigned* ctr = (unsigned*)(p.ws + OFF_BAR) + 8 + layer;
  __shared__ int cur_item;
  for (;;) {
    if (threadIdx.x == 0) cur_item = (int)atomicAdd(ctr, 1u);
    __syncthreads();
    const int idx = cur_item;
    __syncthreads();
    if (idx >= NI) break;
    const int qb = 15 - idx / 96, rem = idx % 96;
    const int bsel = rem >> 5, bh = rem & 31;
    const int br = bsel == 0 ? 1 : (bsel == 1 ? 2 : 0);
    attn_item(p, br, bh >> 3, bh & 7, qb);
  }
}

DI void phase_merge(const Params& p) {
  const u16* xb = (const u16*)(p.ws + OFF_XB);
  const u16* wm_t = (const u16*)(p.ws + OFF_WIN) + (size_t)N1 * DM;
  const u16* wbr_t = (const u16*)(p.ws + OFF_WBR);
  const float* rstd = (const float*)(p.ws + OFF_RSTD);
  u16* merged = (u16*)(p.ws + OFF_MERGED);
  char* scr = p.ws + OFF_SCR + (size_t)blockIdx.x * 384 * 1024;
  u32x2* sig = (u32x2*)scr;
  f32x4* part = (f32x4*)(scr + 128 * 1024);
  const int tid = ltid();
  extern __shared__ __attribute__((aligned(16))) char smem[];
  u16* lds16 = (u16*)smem;
  for (int u = blockIdx.x; u < 256; u += gridDim.x) {
    const int pn = u / 64, pm = u % 64;
    const int brow = pm * 256, bcol = pn * 256;
    for (int nb = 0; nb < 3; ++nb) {
      struct PreG { float rs[4]; };
      gemm_unit(xb, DM, wm_t + (size_t)nb * DM * DM, DM, DM, brow, bcol,
        [&](int ai, int m, int row0, int col0) {
          PreG q; asm volatile("" : "+v"(row0));
#pragma unroll
          for (int j = 0; j < 4; ++j) q.rs[j] = rstd[row0 + j];
          return q;
        },
        [&](int ai, int bj, int m, int n, f32x4 a, int row0, int col, const PreG& q) {
          float v[4];
#pragma unroll
          for (int j = 0; j < 4; ++j) { const float z = a[j] * q.rs[j]; v[j] = __builtin_amdgcn_rcpf(1.f + __expf(-z)); }
          u32x2 o; o[0] = pk2(v[0], v[1]); o[1] = pk2(v[2], v[3]);
          int t_ = tid; asm volatile("" : "+v"(t_));
          sig[(((ai * 2 + bj) * 4 + m) * 2 + n) * 512 + t_] = o;
        });
      const u16* gp = (const u16*)(p.ws + OFF_G0 + (size_t)nb * 16 * MiB);
      struct PreY { u32x2 sg[4]; f32x4 pt[4]; };
      gemm_unit(gp, WID, wbr_t + (size_t)nb * DM * WID, WID, WID, brow, bcol,
        [&](int ai, int m, int row0, int col0) {
          PreY q; int t_ = tid; asm volatile("" : "+v"(t_));
#pragma unroll
          for (int c = 0; c < 4; ++c) {
            const int slot = (((ai * 2 + (c >> 1)) * 4 + m) * 2 + (c & 1)) * 512 + t_;
            q.sg[c] = sig[slot];
            if (nb > 0) q.pt[c] = part[slot]; else { q.pt[c][0] = 0.f; q.pt[c][1] = 0.f; q.pt[c][2] = 0.f; q.pt[c][3] = 0.f; }
          }
          return q;
        },
        [&](int ai, int bj, int m, int n, f32x4 a, int row0, int col, const PreY& q) {
          int t_ = tid; asm volatile("" : "+v"(t_));
          const int slot = (((ai * 2 + bj) * 4 + m) * 2 + n) * 512 + t_;
          const u32x2 sg = q.sg[bj * 2 + n];
          f32x4 v;
          v[0] = a[0] * bf2f(sg[0] & 0xffffu); v[1] = a[1] * bf2f(sg[0] >> 16);
          v[2] = a[2] * bf2f(sg[1] & 0xffffu); v[3] = a[3] * bf2f(sg[1] >> 16);
          v += q.pt[bj * 2 + n];
          if (nb < 2) part[slot] = v;
          else {
#pragma unroll
            for (int j = 0; j < 4; ++j) lds16[(row0 - brow + j) * EPI_LD + (col - bcol)] = f2bf(v[j]);
          }
        });
    }
    tile_copy_out(merged + (size_t)brow * DM + bcol, DM);
  }
}

DI void phase_out(const Params& p, int layer) {
  const u16* merged = (const u16*)(p.ws + OFF_MERGED);
  const u16* wout_t = (const u16*)(p.ws + OFF_WOUT);
  const float* resid = layer == 0 ? p.x : p.out;
  float* out = p.out;
  for (int u = blockIdx.x; u < 256; u += gridDim.x) {
    const int pn = u / 64, pm = u % 64;
    struct PreO { float r[4][4]; };
    gemm_unit(merged, DM, wout_t, DM, DM, pm * 256, pn * 256,
      [&](int ai, int m, int row0, int col0) {
        PreO q; asm volatile("" : "+v"(row0), "+v"(col0));
#pragma unroll
        for (int c = 0; c < 4; ++c)
#pragma unroll
          for (int j = 0; j < 4; ++j) q.r[c][j] = resid[(size_t)(row0 + j) * DM + col0 + (c >> 1) * 128 + (c & 1) * 16];
        return q;
      },
      [&](int ai, int bj, int m, int n, f32x4 a, int row0, int col, const PreO& q) {
#pragma unroll
        for (int j = 0; j < 4; ++j) { const size_t o = (size_t)(row0 + j) * DM + col; out[o] = q.r[bj * 2 + n][j] + a[j]; }
      });
  }
}

DI void phase_final(const Params& p) {
  const int tid_ = ltid(), wave = tid_ >> 6, lane = tid_ & 63;
  const float4* g4 = (const float4*)p.final_gain;
  for (int row = blockIdx.x * 8 + wave; row < T_TOK; row += gridDim.x * 8) {
    float4* s4 = (float4*)(p.out + (size_t)row * DM);
    float4 v[4]; float ss = 0.f;
#pragma unroll
    for (int i = 0; i < 4; ++i) { v[i] = s4[lane + 64 * i]; ss += v[i].x * v[i].x + v[i].y * v[i].y + v[i].z * v[i].z + v[i].w * v[i].w; }
    ss = wave_sum(ss);
    const float rs = rsqrtf(ss * (1.0f / DM) + 1e-6f);
#pragma unroll
    for (int i = 0; i < 4; ++i) {
      const float4 gg = g4[lane + 64 * i];
      float4 o; o.x = v[i].x * rs * gg.x; o.y = v[i].y * rs * gg.y; o.z = v[i].z * rs * gg.z; o.w = v[i].w * rs * gg.w;
      s4[lane + 64 * i] = o;
    }
  }
}


#define XB_TMO      128
#define XB_XCNT(j)  (256  + 64 * (j))
#define XB_XSUB(j)  (1280 + 64 * (j))
#define XB_XGEN(j)  (2304 + 64 * (j))
#define XB_TOP      3328
#define XB_TOPGEN   3392
#define XCD_BAR_WORDS 3456
#define XB_SPIN_CAP (1u << 22)
#define LAS __attribute__((address_space(3)))
DI unsigned xb_ld(unsigned* p)              { return __hip_atomic_load(p, __ATOMIC_RELAXED, __HIP_MEMORY_SCOPE_AGENT); }
DI unsigned xb_add(unsigned* p, unsigned v) { return __hip_atomic_fetch_add(p, v, __ATOMIC_RELAXED, __HIP_MEMORY_SCOPE_AGENT); }
DI unsigned xb_xcc_id() { return (unsigned)__builtin_amdgcn_s_getreg((3 << 11) | 20) & 0xFu; }
#define XB_SPIN(cond, bar) do { unsigned _sp = 0; while (cond) { __builtin_amdgcn_s_sleep(1); \
    if ((++_sp & 255u) == 0u) { if (xb_ld(&(bar)[XB_TMO])) break; if (_sp > XB_SPIN_CAP) { atomicAdd(&(bar)[XB_TMO], 1u); break; } } } } while (0)
struct XcdBarrier { unsigned* bar; unsigned x; volatile LAS unsigned* st; };
DI XcdBarrier xcd_barrier_post(unsigned* bar, volatile LAS unsigned* st) {
  XcdBarrier b; b.bar = bar; b.x = xb_xcc_id(); b.st = st;
  if (threadIdx.x == 0) (void)xb_add(&bar[XB_XCNT(b.x)], 1u);
  return b;
}
DI void xcd_barrier_complete(unsigned* bar, unsigned x, unsigned& nloc, unsigned& nx) {
  const unsigned G = gridDim.x * gridDim.y * gridDim.z;
  unsigned sum, cnt, mine, sp = 0u;
  for (;;) {
    sum = 0u; cnt = 0u; mine = 0u;
#pragma unroll
    for (unsigned j = 0; j < 16; ++j) { const unsigned c = xb_ld(&bar[XB_XCNT(j)]); sum += c; cnt += (c > 0u) ? 1u : 0u; mine = (j == x) ? c : mine; }
    if (sum == G) break;
    __builtin_amdgcn_s_sleep(1);
    if ((++sp & 255u) == 0u) { if (xb_ld(&bar[XB_TMO])) break; if (sp > XB_SPIN_CAP) { atomicAdd(&bar[XB_TMO], 1u); break; } }
  }
  nloc = mine > 0u ? mine : 1u; nx = cnt > 0u ? cnt : 1u;
}
DI void xcd_barrier(const XcdBarrier& b) {
  asm volatile("s_waitcnt vmcnt(0)" ::: "memory");
  __syncthreads();
  if (threadIdx.x == 0) {
    unsigned* bar = b.bar;
    __builtin_amdgcn_s_waitcnt(0);
    unsigned nloc = b.st[0], nx = b.st[1];
    if (nloc == 0u) { xcd_barrier_complete(bar, b.x, nloc, nx); b.st[0] = nloc; b.st[1] = nx; }
    const unsigned old = xb_add(&bar[XB_XSUB(b.x)], 1u);
    const unsigned gen = old / nloc;
    if (old + 1u == (gen + 1u) * nloc) {
      __builtin_amdgcn_fence(__ATOMIC_RELEASE, "agent");
      asm volatile("s_waitcnt vmcnt(0)" ::: "memory");
      const unsigned og = xb_add(&bar[XB_TOP], 1u);
      const unsigned tg = og / nx;
      if (og + 1u == (tg + 1u) * nx) xb_add(&bar[XB_TOPGEN], 1u);
      else XB_SPIN(xb_ld(&bar[XB_TOPGEN]) == tg, bar);
      __builtin_amdgcn_fence(__ATOMIC_ACQUIRE, "agent");
      xb_add(&bar[XB_XGEN(b.x)], 1u);
      asm volatile("s_waitcnt vmcnt(0)" ::: "memory");
    } else {
      XB_SPIN(xb_ld(&bar[XB_XGEN(b.x)]) == gen, bar);
      __builtin_amdgcn_fence(__ATOMIC_ACQUIRE, "agent");
      asm volatile("s_waitcnt vmcnt(0)" ::: "memory");
    }
  }
  __syncthreads();
}

__global__ void __launch_bounds__(NTHR) mega(Params p, int ph_lo, int ph_hi) {
  cg::grid_group grid = cg::this_grid();
  __shared__ uint4 xb_words;
  if (threadIdx.x == 0) xb_words = make_uint4(0u, 0u, 0u, 0u);
  __syncthreads();
  XcdBarrier xb = xcd_barrier_post((unsigned*)(p.ws + OFF_BAR), (volatile LAS unsigned*)&xb_words);
  for (int ph = ph_lo; ph < ph_hi; ++ph) {
    const unsigned long long t_ph0 = (PROBE_K >= 0) ? __builtin_amdgcn_s_memrealtime() : 0ull;
    if (ph == 12) phase_final(p);
    else {
      const int layer = ph / 6, k = ph % 6;
      if (k == 0) phase_prep(p, layer);
      else if (k == 1) phase_proj(p, layer);
      else if (k == 2) phase_select(p, layer);
      else if (k == 3) phase_attn(p, layer);
      else if (k == 4) phase_merge(p);
      else phase_out(p, layer);
    }
    if (PROBE_K >= 0 && ((ph == 12) ? 6 : (ph % 6)) == PROBE_K) {
      const unsigned long long t1 = __builtin_amdgcn_s_memrealtime();
      while (__builtin_amdgcn_s_memrealtime() - t1 < t1 - t_ph0) __builtin_amdgcn_s_sleep(8);
    }
    if (ph + 1 < ph_hi) {
      if (ph_hi > 1000) grid.sync();
      else xcd_barrier(xb);
    }
  }
}

extern "C" void kernel_launch(void* const* d_in, const int* in_sizes, int n_in, void* d_out, int out_size,
                              void* d_ws, size_t ws_size, hipStream_t stream) {
  if (ws_size < WS_NEED) { fprintf(stderr, "workspace too small: %zu < %zu\n", ws_size, (size_t)WS_NEED); return; }
  Params p{};
  p.x = (const float*)d_in[0]; p.norm_gain = (const float*)d_in[1]; p.w_in = (const float*)d_in[2];
  p.fbias = (const float*)d_in[3]; p.w_branch = (const float*)d_in[4]; p.w_out = (const float*)d_in[5];
  p.final_gain = (const float*)d_in[6];
  p.out = (float*)d_out; p.ws = (char*)d_ws;
  (void)hipFuncSetAttribute((const void*)mega, hipFuncAttributeMaxDynamicSharedMemorySize, SMEM_BYTES);
  static int grid = 0;
  if (!grid) {
    int dev = 0, cus = 0, per_cu = 0;
    hipGetDevice(&dev);
    hipDeviceGetAttribute(&cus, hipDeviceAttributeMultiprocessorCount, dev);
    hipOccupancyMaxActiveBlocksPerMultiprocessor(&per_cu, (const void*)mega, NTHR, SMEM_BYTES);
    if (per_cu < 1) per_cu = 1;
    grid = cus;
    if (grid > 256) grid = 256;
  }
  (void)hipMemsetAsync((char*)d_ws + OFF_BAR, 0, 16384, stream);
  int lo = 0, hi = 13;
  void* args[] = {&p, &lo, &hi};
  hipError_t e = hipLaunchCooperativeKernel((const void*)mega, dim3(grid), dim3(NTHR), args, SMEM_BYTES, stream);
  if (e != hipSuccess) fprintf(stderr, "cooperative launch failed: %s (grid %d)\n", hipGetErrorString(e), grid);
}
```
